# Optimizing an MI355X kernel written in HIP

```python
import math
import jax, jax.numpy as jnp
from jax import lax
import numpy as np

D_MODEL = 1024
BATCH = 8
SEQ = 2048
DEPTH = 2
DEC_BATCH = 128
DEC_SEQ = 8
PAST_LEN = 16384
PAGE_SIZE = 128

N_MIXERS = 2
N_A = (DEPTH + N_MIXERS - 1) // N_MIXERS
N_B = DEPTH // N_MIXERS
N_META = 16
EPS = 1e-6
GDN_HEADS = 8
GDN_DK = 128
GDN_DV = 128
GDN_KEY = GDN_HEADS * GDN_DK
GDN_VAL = GDN_HEADS * GDN_DV
GDN_CONV_CH = 2 * GDN_KEY + GDN_VAL
GDN_PROJ = GDN_CONV_CH + GDN_VAL + 2 * GDN_HEADS
GDN_CONV_W = 4
GDN_CHUNK = 64
POOL_WINDOWS = (2, 4, 8, 16)
POOL_GROUPS = 4
POOL_GW = D_MODEL // POOL_GROUPS
POOL_BUF = max(POOL_WINDOWS) - 1
D_FF = 2816
FFN_CONV_W = 3

kernel_name = 'gdn_pool_convffn_hybrid_step'


def rmsnorm(x, w):
    xf = x.astype(jnp.float32)
    y = xf * lax.rsqrt(jnp.mean(xf * xf, axis=-1, keepdims=True) + EPS)
    return (y * w.astype(jnp.float32)).astype(x.dtype)


def l2norm(x):
    return x * lax.rsqrt(jnp.sum(x * x, axis=-1, keepdims=True) + EPS)


def causal_dwconv(prev, x, w):
    width = w.shape[0]
    L = x.shape[1]
    xcat = jnp.concatenate([prev.astype(x.dtype), x], axis=1)
    out = w[0].astype(x.dtype) * xcat[:, :L]
    for j in range(1, width):
        out = out + w[j].astype(x.dtype) * xcat[:, j:j + L]
    return out, xcat[:, L:]


def _to_blocks(t, pad, chunk):
    t = jnp.pad(t, [(0, 0), (pad, 0)] + [(0, 0)] * (t.ndim - 2))
    t = t.reshape((t.shape[0], t.shape[1] // chunk, chunk) + t.shape[2:])
    return jnp.moveaxis(t, 3, 1)


def gated_delta_rule(q, k, v, g, beta, S0, chunk):
    B, L, H, _ = q.shape
    DV = v.shape[-1]
    pad = (-L) % chunk
    q, k, v, g, beta = [_to_blocks(t.astype(jnp.float32), pad, chunk) for t in (q, k, v, g, beta)]
    G = jnp.cumsum(g, axis=-1)
    idx = jnp.arange(chunk)
    causal = idx[:, None] >= idx[None, :]
    strict = idx[:, None] > idx[None, :]
    decay = jnp.exp(jnp.where(causal, G[..., :, None] - G[..., None, :], -jnp.inf))
    kk = jnp.einsum('bhnid,bhnjd->bhnij', k, k)
    lower = jnp.where(strict, beta[..., :, None] * kk * decay, 0.0)
    eye = jnp.eye(chunk, dtype=jnp.float32)
    T = lax.linalg.triangular_solve(lower + eye, jnp.broadcast_to(eye, lower.shape),
                                    left_side=True, lower=True, unit_diagonal=True)
    U = jnp.einsum('bhnij,bhnje->bhnie', T, v * beta[..., None])
    W = jnp.einsum('bhnij,bhnjd->bhnid', T, k * (beta * jnp.exp(G))[..., None])
    A = jnp.einsum('bhnid,bhnjd->bhnij', q, k) * decay
    q_dec = q * jnp.exp(G)[..., None]
    k_dec = k * jnp.exp(G[..., -1:] - G)[..., None]
    g_tot = jnp.exp(G[..., -1])
    blocks = tuple(jnp.moveaxis(t, 2, 0) for t in (U, W, A, q_dec, k_dec, g_tot))

    def step(S, blk):
        U_c, W_c, A_c, qd_c, kd_c, gt_c = blk
        v_new = U_c - jnp.einsum('bhid,bhde->bhie', W_c, S)
        o = jnp.einsum('bhid,bhde->bhie', qd_c, S) + jnp.einsum('bhij,bhje->bhie', A_c, v_new)
        S = S * gt_c[..., None, None] + jnp.einsum('bhid,bhie->bhde', kd_c, v_new)
        return S, o

    S, o = lax.scan(step, S0.astype(jnp.float32), blocks)
    o = jnp.transpose(o, (1, 0, 3, 2, 4)).reshape(B, -1, H, DV)[:, pad:]
    return o, S


def gdn_mixer(h, conv_prev, S0, w_in, conv_w, A_log, dt_bias, norm_w, w_out, chunk):
    B, L, _ = h.shape
    proj = jnp.einsum('bld,de->ble', h, w_in)
    qkv = proj[..., :GDN_CONV_CH]
    z = proj[..., GDN_CONV_CH:GDN_CONV_CH + GDN_VAL]
    b_logit = proj[..., GDN_CONV_CH + GDN_VAL:GDN_CONV_CH + GDN_VAL + GDN_HEADS]
    a_logit = proj[..., GDN_CONV_CH + GDN_VAL + GDN_HEADS:]
    qkv_c, conv_new = causal_dwconv(conv_prev, qkv, conv_w)
    qkv_c = jax.nn.silu(qkv_c.astype(jnp.float32))
    q = qkv_c[..., :GDN_KEY].reshape(B, L, GDN_HEADS, GDN_DK)
    k = qkv_c[..., GDN_KEY:2 * GDN_KEY].reshape(B, L, GDN_HEADS, GDN_DK)
    v = qkv_c[..., 2 * GDN_KEY:].reshape(B, L, GDN_HEADS, GDN_DV)
    q = l2norm(q) * (GDN_DK ** -0.5)
    k = l2norm(k)
    beta = jax.nn.sigmoid(b_logit.astype(jnp.float32))
    g = -jnp.exp(A_log.astype(jnp.float32)) * jax.nn.softplus(
        a_logit.astype(jnp.float32) + dt_bias.astype(jnp.float32))
    o, S = gated_delta_rule(q, k, v, g, beta, S0, chunk)
    o = o * lax.rsqrt(jnp.mean(o * o, axis=-1, keepdims=True) + EPS) * norm_w.astype(jnp.float32)
    o = o * jax.nn.silu(z.astype(jnp.float32)).reshape(B, L, GDN_HEADS, GDN_DV)
    out = jnp.einsum('ble,ed->bld', o.reshape(B, L, GDN_VAL).astype(h.dtype), w_out)
    return out, conv_new, S


def pool_mixer(h, prev, start_pos, w_grp, scale):
    B, L, _ = h.shape
    hcat = jnp.concatenate([prev.astype(h.dtype), h], axis=1)
    csum = jnp.cumsum(hcat.astype(jnp.float32), axis=1)
    csum = jnp.concatenate([jnp.zeros((B, 1, D_MODEL), jnp.float32), csum], axis=1)
    off = POOL_BUF + 1
    pos = start_pos + jnp.arange(L)
    hf = h.astype(jnp.float32)
    outs = []
    for gi, win in enumerate(POOL_WINDOWS):
        lo, hi = gi * POOL_GW, (gi + 1) * POOL_GW
        wsum = csum[:, off:off + L, lo:hi] - csum[:, off - win:off - win + L, lo:hi]
        cnt = jnp.minimum(win, pos + 1).astype(jnp.float32)[None, :, None]
        pooled = wsum / cnt - hf[..., lo:hi]
        outs.append(jnp.einsum('blc,ce->ble', pooled, w_grp[gi].astype(jnp.float32)))
    out = jnp.concatenate(outs, axis=-1) * scale.astype(jnp.float32)
    return out.astype(h.dtype), hcat[:, L:]


def conv_ffn(h, prev, w_up, conv_w, conv_b, w_down):
    u = jnp.einsum('bld,df->blf', h, w_up)
    uc, buf = causal_dwconv(prev, u, conv_w)
    uc = uc + conv_b.astype(uc.dtype)
    a, b = uc[..., :D_FF], uc[..., D_FF:]
    return jnp.einsum('blf,fd->bld', jax.nn.silu(a) * b, w_down), buf


def trunk(x, gdn_conv_prev, gdn_S0, pool_prev, ffn_prev, start_pos, chunk,
          norm_mix, norm_ffn, gdn_w_in, gdn_conv_w, gdn_A_log, gdn_dt_bias, gdn_norm_w, gdn_w_out,
          pool_w, pool_scale, ffn_w_up, ffn_conv_w, ffn_conv_b, ffn_w_down, norm_final):
    conv_new, S_new, pool_new, ffn_new = [], [], [], []
    for i in range(DEPTH):
        j = i // N_MIXERS
        h = rmsnorm(x, norm_mix[i])
        if i % N_MIXERS == 0:
            m, c, S = gdn_mixer(h, gdn_conv_prev[j], gdn_S0[j], gdn_w_in[j], gdn_conv_w[j],
                                gdn_A_log[j], gdn_dt_bias[j], gdn_norm_w[j], gdn_w_out[j], chunk)
            conv_new.append(c)
            S_new.append(S)
        else:
            m, pbuf = pool_mixer(h, pool_prev[j], start_pos, pool_w[j], pool_scale[j])
            pool_new.append(pbuf)
        x = x + m.astype(x.dtype)
        h = rmsnorm(x, norm_ffn[i])
        f, fbuf = conv_ffn(h, ffn_prev[i], ffn_w_up[i], ffn_conv_w[i], ffn_conv_b[i], ffn_w_down[i])
        ffn_new.append(fbuf)
        x = x + f.astype(x.dtype)
    y = rmsnorm(x, norm_final)
    return y, jnp.stack(conv_new), jnp.stack(S_new), jnp.stack(pool_new), jnp.stack(ffn_new)


def setup_inputs(seed: int = 0) -> dict:
    key = jax.random.key(seed)
    ks = jax.random.split(key, 22)

    def nrm(k, shape, s):
        return jax.random.normal(k, shape, jnp.float32) * s

    dt = jnp.exp(jax.random.uniform(ks[12], (N_A, GDN_HEADS), jnp.float32,
                                    minval=math.log(1e-3), maxval=math.log(1e-1)))
    return {
        'x_prompt': nrm(ks[0], (BATCH, SEQ, D_MODEL), 1.0),
        'x_sample': nrm(ks[1], (DEC_BATCH, DEC_SEQ, D_MODEL), 1.0),
        'state_gdn_conv': nrm(ks[2], (N_A, DEC_BATCH, GDN_CONV_W - 1, GDN_CONV_CH), 1.0),
        'state_gdn_rec': nrm(ks[3], (N_A, DEC_BATCH, GDN_HEADS, GDN_DK, GDN_DV), GDN_DK ** -0.5),
        'state_pool': nrm(ks[4], (N_B, DEC_BATCH, POOL_BUF, D_MODEL), 1.0),
        'state_ffn_conv': nrm(ks[5], (DEPTH, DEC_BATCH, FFN_CONV_W - 1, 2 * D_FF), 1.0),
        'meta_tokens': nrm(ks[6], (N_META, D_MODEL), 1.0),
        'norm_mix': 1.0 + nrm(ks[7], (DEPTH, D_MODEL), 0.02),
        'norm_ffn': 1.0 + nrm(ks[8], (DEPTH, D_MODEL), 0.02),
        'gdn_w_in': nrm(ks[9], (N_A, D_MODEL, GDN_PROJ), D_MODEL ** -0.5),
        'gdn_conv_w': nrm(ks[10], (N_A, GDN_CONV_W, GDN_CONV_CH), GDN_CONV_W ** -0.5),
        'gdn_A_log': jnp.log(jax.random.uniform(ks[11], (N_A, GDN_HEADS), jnp.float32, minval=1.0, maxval=16.0)),
        'gdn_dt_bias': dt + jnp.log(-jnp.expm1(-dt)),
        'gdn_norm_w': 1.0 + nrm(ks[13], (N_A, GDN_DV), 0.02),
        'gdn_w_out': nrm(ks[14], (N_A, GDN_VAL, D_MODEL), GDN_VAL ** -0.5),
        'pool_w': nrm(ks[15], (N_B, POOL_GROUPS, POOL_GW, POOL_GW), POOL_GW ** -0.5),
        'pool_scale': 1.0 + nrm(ks[16], (N_B, D_MODEL), 0.05),
        'ffn_w_up': nrm(ks[17], (DEPTH, D_MODEL, 2 * D_FF), D_MODEL ** -0.5),
        'ffn_conv_w': nrm(ks[18], (DEPTH, FFN_CONV_W, 2 * D_FF), FFN_CONV_W ** -0.5),
        'ffn_conv_b': nrm(ks[19], (DEPTH, 2 * D_FF), 0.01),
        'ffn_w_down': nrm(ks[20], (DEPTH, D_FF, D_MODEL), D_FF ** -0.5),
        'norm_final': 1.0 + nrm(ks[21], (D_MODEL,), 0.02),
    }


def reference(x_prompt, x_sample, state_gdn_conv, state_gdn_rec, state_pool, state_ffn_conv,
              meta_tokens, norm_mix, norm_ffn, gdn_w_in, gdn_conv_w, gdn_A_log, gdn_dt_bias,
              gdn_norm_w, gdn_w_out, pool_w, pool_scale, ffn_w_up, ffn_conv_w, ffn_conv_b,
              ffn_w_down, norm_final):
    Bp = x_prompt.shape[0]
    dtp = x_prompt.dtype
    meta = jnp.broadcast_to(meta_tokens.astype(dtp)[None], (Bp, N_META, D_MODEL))
    xp = jnp.concatenate([meta, x_prompt], axis=1)
    zc = jnp.zeros((N_A, Bp, GDN_CONV_W - 1, GDN_CONV_CH), dtp)
    zS = jnp.zeros((N_A, Bp, GDN_HEADS, GDN_DK, GDN_DV), jnp.float32)
    zp = jnp.zeros((N_B, Bp, POOL_BUF, D_MODEL), dtp)
    zf = jnp.zeros((DEPTH, Bp, FFN_CONV_W - 1, 2 * D_FF), dtp)
    yp, p_conv, p_rec, p_pool, p_ffn = trunk(
        xp, zc, zS, zp, zf, 0, GDN_CHUNK,
        norm_mix, norm_ffn, gdn_w_in, gdn_conv_w, gdn_A_log, gdn_dt_bias, gdn_norm_w, gdn_w_out,
        pool_w, pool_scale, ffn_w_up, ffn_conv_w, ffn_conv_b, ffn_w_down, norm_final)
    y_sample, s_conv, s_rec, s_pool, s_ffn = trunk(
        x_sample, state_gdn_conv, state_gdn_rec, state_pool, state_ffn_conv, PAST_LEN,
        min(GDN_CHUNK, x_sample.shape[1]),
        norm_mix, norm_ffn, gdn_w_in, gdn_conv_w, gdn_A_log, gdn_dt_bias, gdn_norm_w, gdn_w_out,
        pool_w, pool_scale, ffn_w_up, ffn_conv_w, ffn_conv_b, ffn_w_down, norm_final)
    y_prompt = yp[:, N_META:]
    return (y_prompt, y_sample, p_conv, p_rec, p_pool, p_ffn, s_conv, s_rec, s_pool, s_ffn)
```

```cpp
#include <hip/hip_runtime.h>
#include <hip/hip_cooperative_groups.h>
#include <cstdio>
#include <cstdint>
namespace cg = cooperative_groups;

#define LAS __attribute__((address_space(3)))
typedef unsigned short bf16_t;
typedef short bf16x8 __attribute__((ext_vector_type(8)));
typedef float f32x4 __attribute__((ext_vector_type(4)));
typedef float f32x2 __attribute__((ext_vector_type(2)));
typedef unsigned u32x4 __attribute__((ext_vector_type(4)));
typedef unsigned u32x2 __attribute__((ext_vector_type(2)));

constexpr int D = 1024, BATCH = 8, SEQ = 2048, NMETA = 16, LP = SEQ + NMETA  , NPROMPT = BATCH * LP  ;
constexpr int DECB = 128, DECS = 8, NSAMP = DECB * DECS  , T = NPROMPT + NSAMP  , TP = 17664  ;
constexpr int NH = 8, DK = 128, DV = 128, CONVCH = 3072, GPROJ = 4112, DFF = 2816, DFF2 = 5632;
constexpr float EPS = 1e-6f;
constexpr int NWAVES = 8, NTHREADS = 512;
#ifndef REP_G1
#define REP_G1 1
#endif
#ifndef REP_P3
#define REP_P3 1
#endif
#ifndef REP_UP
#define REP_UP 1
#endif
#ifndef REP_RN
#define REP_RN 1
#endif

constexpr size_t O_YP = 0, O_YS = O_YP + (size_t)BATCH * SEQ * D, O_PCONV = O_YS + (size_t)NSAMP * D, O_PREC = O_PCONV + (size_t)BATCH * 3 * CONVCH,
                 O_PPOOL = O_PREC + (size_t)BATCH * NH * DK * DV, O_PFFN = O_PPOOL + (size_t)BATCH * 15 * D, O_SCONV = O_PFFN + (size_t)2 * BATCH * 2 * DFF2,
                 O_SREC = O_SCONV + (size_t)DECB * 3 * CONVCH, O_SPOOL = O_SREC + (size_t)DECB * NH * DK * DV, O_SFFN = O_SPOOL + (size_t)DECB * 15 * D,
                 O_END = O_SFFN + (size_t)2 * DECB * 2 * DFF2;

constexpr size_t MiB = 1u << 20;
constexpr size_t WS_CTL = 0, WS_GT = 128 * 1024, WS_RSS = 256 * 1024  , WS_WOUT = 1 * MiB, WS_BG = 3 * MiB, WS_QKV = 5 * MiB, WS_Z = 109 * MiB, WS_R1 = 144 * MiB, WS_HB0 = 144 * MiB, WS_WIN = 179 * MiB;
constexpr size_t WS_X = 5 * MiB, WS_XB = 74 * MiB  , WS_ACT = 109 * MiB, WS_WUP = 220 * MiB, WS_WDN = 242 * MiB, WS_WP = 253 * MiB, WS_END = 256 * MiB;
constexpr int N_REC_WS = (int)((WS_END - WS_R1) / 73728);
static_assert(WS_QKV + (size_t)TP * CONVCH * 2 <= WS_Z && WS_Z + (size_t)TP * D * 2 <= WS_R1 && WS_HB0 + (size_t)TP * D * 2 <= WS_WIN && WS_WIN + (size_t)4352 * D * 2 <= WS_END, "ws map 1");
static_assert(WS_RSS + (size_t)3 * TP * 4 <= WS_WOUT && WS_X + (size_t)TP * D * 4 <= WS_XB && WS_XB + (size_t)TP * D * 2 <= WS_ACT && WS_ACT + (size_t)TP * DFF * 2 <= WS_WUP && WS_WUP + (size_t)2 * DFF2 * D * 2 <= WS_WDN && WS_WDN + (size_t)2 * D * DFF * 2 <= WS_WP && WS_WP + (size_t)D * 256 * 2 <= WS_END, "ws map 2");
static_assert((size_t)(2112 - N_REC_WS) * 73728 <= (size_t)BATCH * SEQ * D * 4, "GDN records spill into y_prompt");
constexpr int LDS_BYTES = 163840;
constexpr int LDS_MISC = 163776;
constexpr int LDS_BND = 131072;

__device__ __forceinline__ float bf2f(bf16_t b) { return __uint_as_float(((unsigned)b) << 16); }
typedef __bf16 bf16x2_t __attribute__((ext_vector_type(2)));
__device__ __forceinline__ unsigned cvt_pk_bf16(float lo, float hi) { const bf16x2_t r = __builtin_convertvector((f32x2){lo, hi}, bf16x2_t); return __builtin_bit_cast(unsigned, r); }
__device__ __forceinline__ float silu_f(float x) { return x * __builtin_amdgcn_rcpf(1.0f + __expf(-x)); }
__device__ __forceinline__ float wave_sum(float v) {
#pragma unroll
    for (int o = 1; o < 64; o <<= 1) v += __shfl_xor(v, o);
    return v;
}
__device__ __forceinline__ const float* x0_row(const float* xp, const float* xs, const float* meta, int r) {
    if (r < NPROMPT) { const int b = r / LP, t = r - b * LP; return t < NMETA ? meta + (size_t)t * D : xp + ((size_t)b * SEQ + (t - NMETA)) * D; }
    if (r < T) return xs + (size_t)(r - NPROMPT) * D;
    return nullptr;
}
__device__ __forceinline__ int fresh_tid() { int t = threadIdx.x; asm volatile("" : "+v"(t)); return t; }
template <int CTRL> __device__ __forceinline__ float dpp_r(float src) {
    return __builtin_bit_cast(float, __builtin_amdgcn_update_dpp(__builtin_bit_cast(int, src), __builtin_bit_cast(int, src), CTRL, 0xf, 0xf, false));
}
template <int CTRL> __device__ __forceinline__ float dpp_f(float old, float src) {
    return __builtin_bit_cast(float, __builtin_amdgcn_update_dpp(__builtin_bit_cast(int, old), __builtin_bit_cast(int, src), CTRL, 0xf, 0xf, false));
}

namespace pg8 {
constexpr int BM = 256, BK = 64, HALF = 128, HTB = HALF * BK * 2, STAGE_BYTES = 8 * HTB, NXCD = 8, WGM = 8;
__host__ __device__ __forceinline__ int lds_byte(int r, int c) { const int st = (r >> 4) * 2 + (c >> 5), rr = r & 15, cc = c & 31, ob = rr * 64 + cc * 2; return st * 1024 + (ob ^ (((ob >> 9) & 1) << 5)); }
__host__ __device__ __forceinline__ void stage_rc(int b, int& R, int& C) { const int st = b / 1024, sb = b % 1024, swz = sb ^ (((sb >> 9) & 1) << 5); R = (st >> 1) * 16 + swz / 64; C = (st & 1) * 32 + (swz % 64) / 2; }
__host__ __device__ __forceinline__ int perm32(int rho) { const int n = rho >> 4, i = rho & 15; return 8 * (i >> 2) + 4 * n + (i & 3); }

struct Unit { int pm, pn, q; };
struct Gemm { const bf16_t* A; const bf16_t* Bt; int lda, K; int a_colstep; };

__device__ __forceinline__ int tile_row0(int pm, bool ffn) { return ffn ? (pm < 65 ? 254 * pm : NPROMPT + 256 * (pm - 65)) : 256 * pm; }

struct StaticOrder {
    int nM, nN, nwg, G, c; bool ffn, samp;
    __device__ void init(int nM_, int nN_, int G_, int c_, bool ffn_, bool samp_ = false) { nM = ffn_ ? 65 : nM_; nN = nN_; nwg = nM * nN; G = G_; c = c_; ffn = ffn_; samp = samp_; }
    __device__ bool next(int i, Unit& u) const {
        u.q = 0;
        if (samp) { int sidx = c - nwg % G; if (sidx < 0) sidx += G; if (i > 0 || sidx >= 4 * nN) return false; u.pm = 65 + (sidx & 3); u.pn = sidx >> 2; return true; }
        const long L = (long)i * G + c; if (L >= nwg) return false;
        int wgid = (int)L; { const int q = nwg / NXCD, r = nwg % NXCD, xcd = wgid % NXCD, off = wgid / NXCD; wgid = (xcd < r ? xcd * (q + 1) : r * (q + 1) + (xcd - r) * q) + off; }
        const int nig = WGM * nN, gid = wgid / nig, fm = gid * WGM, gsz = (nM - fm) < WGM ? (nM - fm) : WGM;
        u.pm = fm + ((wgid % nig) % gsz); u.pn = (wgid % nig) / gsz; return true;
    }
};

struct TailOrder : StaticOrder {
    __device__ __forceinline__ bool next(int i, Unit& u) const {
        const int rows1 = (G / nN) < nM ? (G / nN) : nM, n1 = rows1 * nN;
        int pm = 0, pn = 0, q = 0; bool ok = true;
        if (i == 0 && c < n1) {
            int wgid = c; { const int qq = n1 / NXCD, r = n1 % NXCD, xcd = wgid % NXCD, off = wgid / NXCD; wgid = (xcd < r ? xcd * (qq + 1) : r * (qq + 1) + (xcd - r) * qq) + off; }
            const int nig = WGM * nN, gid = wgid / nig, fm = gid * WGM, gsz = (rows1 - fm) < WGM ? (rows1 - fm) : WGM;
            pm = fm + ((wgid % nig) % gsz); pn = (wgid % nig) / gsz;
        } else {
            const int idx = i == 0 ? (c - n1) : (G - n1) + (i - 1) * G + c;
            ok = idx < 2 * (nM - rows1) * nN;
            const int t = idx >> 1; pm = rows1 + t / nN; pn = t % nN; q = 1 + (idx & 1);
        }
        u.pm = pm; u.pn = pn; u.q = q; return ok;
    }
};

template <class Epi, bool ALIGN_EPI, bool SP2, class Ord = StaticOrder>
__device__ __forceinline__ void gemm_phase(LAS unsigned char* lds, const Gemm g, const Ord& S, const Epi& E) {
    const int tid = fresh_tid(), wid = __builtin_amdgcn_readfirstlane(tid >> 6), lane = tid & 63, wr = wid >> 2, wc = wid & 3, fr = lane & 15, fq = lane >> 4;
    int K_ = g.K, lda_ = g.lda, acs_ = g.a_colstep; asm volatile("" : "+s"(K_), "+s"(lda_), "+s"(acs_));
    const int K = K_, nt = K / BK, lda = lda_, acs = acs_;
    unsigned voffA[2], voffB[2];
#pragma unroll
    for (int i = 0; i < 2; ++i) { int R, C; stage_rc(tid * 16 + i * 8192, R, C); const int Rb = Epi::PERM ? ((R & ~31) + perm32(R & 31)) : R;
        voffA[i] = (unsigned)(R * lda + C) * 2u; voffB[i] = (unsigned)(Rb * K + C) * 2u; }
    const size_t kstep = (size_t)(BK * 2);
    const size_t hstepA = (size_t)HALF * lda * 2, hstepB = (size_t)HALF * K * 2;
    const size_t tstepB = 2 * hstepB;
    const unsigned ldsw = (unsigned)wid * 1024u;
    const int aoff = lds_byte(wr * 64 + fr, fq * 8), boff = lds_byte(wc * 32 + fr, fq * 8);
#define PG8_SA(b, h) (((b) * 2 + (h)) * HTB)
#define PG8_SB(b, h) ((4 + (b) * 2 + (h)) * HTB)
#define PG8_STAGE(bufoff, gbase, voff) do { _Pragma("unroll") for (int _i = 0; _i < 2; ++_i) \
        __builtin_amdgcn_global_load_lds((const unsigned*)((const char*)(gbase) + (voff)[_i]), (LAS unsigned*)(lds + (bufoff) + ldsw + _i * 8192), 16, 0, 0); } while (0)
#define PG8_LDA(dst, b, h) do { _Pragma("unroll") for (int m = 0; m < 4; ++m) _Pragma("unroll") for (int k = 0; k < 2; ++k) dst[m][k] = *(const LAS bf16x8*)(lds + PG8_SA(b, h) + aoff + m * 2048 + k * 1024); } while (0)
#define PG8_LDB(dst, b, h) do { _Pragma("unroll") for (int n = 0; n < 2; ++n) _Pragma("unroll") for (int k = 0; k < 2; ++k) dst[n][k] = *(const LAS bf16x8*)(lds + PG8_SB(b, h) + boff + n * 2048 + k * 1024); } while (0)
#define PG8_MMA(ai, bj, At, Bt) do { __builtin_amdgcn_s_setprio(1); _Pragma("unroll") for (int m = 0; m < 4; ++m) _Pragma("unroll") for (int n = 0; n < 2; ++n) _Pragma("unroll") for (int k = 0; k < 2; ++k) \
        acc[ai][bj][m][n] = __builtin_amdgcn_mfma_f32_16x16x32_bf16(Bt[n][k], At[m][k], acc[ai][bj][m][n], 0, 0, 0); __builtin_amdgcn_s_setprio(0); } while (0)
#define PG8_WAIT_V(n) asm volatile("s_waitcnt vmcnt(" #n ")" ::: "memory")
#define PG8_WAIT_L(n) asm volatile("s_waitcnt lgkmcnt(" #n ")" ::: "memory")
#define PG8_BAR __builtin_amdgcn_s_barrier()
#define PG8_SCHED __builtin_amdgcn_sched_barrier(0)
    Unit cur, nxt; int ui = 0;
    if (!S.next(0, cur)) return;
    f32x4 acc[2][2][4][2];
#pragma unroll
    for (int a = 0; a < 2; ++a)
#pragma unroll
        for (int b = 0; b < 2; ++b)
#pragma unroll
            for (int m = 0; m < 4; ++m)
#pragma unroll
                for (int n = 0; n < 2; ++n) acc[a][b][m][n] = (f32x4){0.f, 0.f, 0.f, 0.f};
    bf16x8 At[4][2], B0[2][2], B1[2][2];
#define PG8_ROW0(u) (tile_row0((u).pm, S.ffn) + ((u).q == 2 ? HALF : 0))
    const char* cA = (const char*)g.A + ((size_t)PG8_ROW0(cur) * lda + (size_t)cur.pn * acs) * 2; const char* cB = (const char*)g.Bt + (size_t)cur.pn * tstepB;
    if constexpr (SP2) {
        PG8_STAGE(PG8_SB(0, 0), cB, voffB); PG8_STAGE(PG8_SB(0, 1), cB + hstepB, voffB); PG8_STAGE(PG8_SA(0, 0), cA, voffA); PG8_STAGE(PG8_SA(0, 1), cA + hstepA, voffA);
        if (wr == 1) PG8_BAR;
        PG8_WAIT_V(2); PG8_BAR;
        PG8_STAGE(PG8_SB(1, 0), cB + kstep, voffB); PG8_STAGE(PG8_SA(1, 0), cA + kstep, voffA); PG8_STAGE(PG8_SB(1, 1), cB + hstepB + kstep, voffB);
        PG8_WAIT_V(6); PG8_BAR;
    } else {
        PG8_STAGE(PG8_SB(0, 0), cB, voffB); PG8_STAGE(PG8_SA(0, 0), cA, voffA); PG8_STAGE(PG8_SB(0, 1), cB + hstepB, voffB); PG8_STAGE(PG8_SA(0, 1), cA + hstepA, voffA);
        if (wr == 1) PG8_BAR;
        PG8_WAIT_V(4); PG8_BAR;
        PG8_STAGE(PG8_SB(1, 0), cB + kstep, voffB); PG8_STAGE(PG8_SA(1, 0), cA + kstep, voffA); PG8_STAGE(PG8_SB(1, 1), cB + hstepB + kstep, voffB);
        PG8_WAIT_V(6); PG8_BAR;
    }
    for (;;) {
        const bool has_next = S.next(ui + 1, nxt);
        const char* nA = has_next ? (const char*)g.A + ((size_t)PG8_ROW0(nxt) * lda + (size_t)nxt.pn * acs) * 2 : cA; const char* nB = has_next ? (const char*)g.Bt + (size_t)nxt.pn * tstepB : cB;
#pragma unroll 1
        for (int t = 0; t < nt; t += 2) {
            const bool last = (t == nt - 2);
            const char* a1 = cA + (size_t)(t + 1) * kstep;
            const char* a2 = last ? nA : cA + (size_t)(t + 2) * kstep; const char* b2 = last ? nB : cB + (size_t)(t + 2) * kstep;
            const char* a3 = a2 + kstep; const char* b3 = b2 + kstep;
            int full = __builtin_amdgcn_readfirstlane(cur.q == 0 ? 1 : 0); asm volatile("" : "+s"(full));
            if constexpr (SP2) {
            PG8_LDB(B0, 0, 0); PG8_LDB(B1, 0, 1); PG8_SCHED; PG8_LDA(At, 0, 0); PG8_STAGE(PG8_SA(1, 1), a1 + hstepA, voffA);
            PG8_WAIT_V(8); PG8_WAIT_L(0); PG8_BAR; PG8_MMA(0, 0, At, B0); PG8_MMA(0, 1, At, B1); PG8_BAR; PG8_SCHED;
            PG8_LDA(At, 0, 1); PG8_STAGE(PG8_SB(0, 0), b2, voffB); PG8_STAGE(PG8_SB(0, 1), b2 + hstepB, voffB); PG8_STAGE(PG8_SA(0, 0), a2, voffA);
            PG8_WAIT_V(8); PG8_WAIT_L(0); PG8_BAR; if (full) { PG8_MMA(1, 0, At, B0); PG8_MMA(1, 1, At, B1); } PG8_BAR; PG8_SCHED;
            PG8_LDB(B0, 1, 0); PG8_LDB(B1, 1, 1); PG8_SCHED; PG8_LDA(At, 1, 0); PG8_STAGE(PG8_SA(0, 1), a2 + hstepA, voffA);
            PG8_WAIT_V(8); PG8_WAIT_L(0); PG8_BAR; PG8_MMA(0, 0, At, B0); PG8_MMA(0, 1, At, B1); PG8_BAR; PG8_SCHED;
            PG8_LDA(At, 1, 1); PG8_STAGE(PG8_SB(1, 0), b3, voffB); PG8_STAGE(PG8_SB(1, 1), b3 + hstepB, voffB); PG8_STAGE(PG8_SA(1, 0), a3, voffA);
            PG8_WAIT_V(8); PG8_WAIT_L(0); PG8_BAR; if (full) { PG8_MMA(1, 0, At, B0); PG8_MMA(1, 1, At, B1); } PG8_BAR; PG8_SCHED;
            } else {
            PG8_LDB(B0, 0, 0); PG8_SCHED; PG8_LDA(At, 0, 0); PG8_STAGE(PG8_SA(1, 1), a1 + hstepA, voffA);
            PG8_WAIT_L(8); PG8_BAR; PG8_WAIT_L(0); PG8_MMA(0, 0, At, B0); PG8_BAR; PG8_SCHED;
            PG8_LDB(B1, 0, 1); PG8_STAGE(PG8_SB(0, 0), b2, voffB);
            PG8_BAR; PG8_WAIT_L(0); PG8_MMA(0, 1, At, B1); PG8_BAR;
            PG8_LDA(At, 0, 1); PG8_STAGE(PG8_SA(0, 0), a2, voffA);
            PG8_BAR; PG8_WAIT_L(0); PG8_MMA(1, 0, At, B0); PG8_BAR; PG8_SCHED;
            PG8_STAGE(PG8_SB(0, 1), b2 + hstepB, voffB);
            PG8_WAIT_V(6); PG8_BAR; PG8_MMA(1, 1, At, B1); PG8_BAR;
            PG8_LDB(B0, 1, 0); PG8_SCHED; PG8_LDA(At, 1, 0); PG8_STAGE(PG8_SA(0, 1), a2 + hstepA, voffA);
            PG8_WAIT_L(8); PG8_BAR; PG8_WAIT_L(0); PG8_MMA(0, 0, At, B0); PG8_BAR; PG8_SCHED;
            PG8_LDB(B1, 1, 1); PG8_STAGE(PG8_SB(1, 0), b3, voffB);
            PG8_BAR; PG8_WAIT_L(0); PG8_MMA(0, 1, At, B1); PG8_BAR;
            PG8_LDA(At, 1, 1); PG8_STAGE(PG8_SA(1, 0), a3, voffA);
            PG8_BAR; PG8_WAIT_L(0); PG8_MMA(1, 0, At, B0); PG8_BAR; PG8_SCHED;
            PG8_STAGE(PG8_SB(1, 1), b3 + hstepB, voffB);
            PG8_WAIT_V(6); PG8_BAR; PG8_MMA(1, 1, At, B1); PG8_BAR;
            }
        }
        if constexpr (ALIGN_EPI) { if (wr == 0) PG8_BAR; }
        E(acc, cur, PG8_ROW0(cur), wr, wc, fr, fq);
        if (!has_next) break;
#pragma unroll
        for (int a = 0; a < 2; ++a)
#pragma unroll
            for (int b = 0; b < 2; ++b)
#pragma unroll
                for (int m = 0; m < 4; ++m)
#pragma unroll
                    for (int n = 0; n < 2; ++n) acc[a][b][m][n] = (f32x4){0.f, 0.f, 0.f, 0.f};
        cur = nxt; cA = nA; cB = nB; ++ui;
        if constexpr (ALIGN_EPI) { if (wr == 1) PG8_BAR; }
    }
    PG8_WAIT_V(0);
    if constexpr (!ALIGN_EPI) { if (wr == 0) PG8_BAR; }
    PG8_BAR;
#undef PG8_ROW0
#undef PG8_SA
#undef PG8_SB
#undef PG8_STAGE
#undef PG8_LDA
#undef PG8_LDB
#undef PG8_MMA
#undef PG8_WAIT_V
#undef PG8_WAIT_L
#undef PG8_BAR
#undef PG8_SCHED
}

struct EpiQKVZ {
    static constexpr bool PERM = true;
    bf16_t* qkv; bf16_t* zb; float* bg; const float* A_log; const float* dt_bias;
    __device__ __forceinline__ void operator()(f32x4 (&acc)[2][2][4][2], const Unit& u, int row0t, int wr, int wc, int fr, int fq) const {
        if (u.pn == 16) {
            if (wc == 0 && fq < 2) {
                float nA[4], db[4];
#pragma unroll
                for (int e = 0; e < 4; ++e) { nA[e] = 0.f; db[e] = 0.f; }
#pragma unroll
                for (int ai = 0; ai < 2; ++ai)
#pragma unroll
                    for (int m = 0; m < 4; ++m) { const int r = row0t + wr * 64 + fr + ai * HALF + m * 16;
#pragma unroll
                        for (int n = 0; n < 2; ++n) { const f32x4 v = acc[ai][0][m][n]; f32x4 o;
                            if (fq == 0) {
#pragma unroll
                                for (int e = 0; e < 4; ++e) o[e] = 1.0f / (1.0f + __expf(-v[e])); }
                            else {
#pragma unroll
                                for (int e = 0; e < 4; ++e) { const int h = 4 * n + e; const float xx = v[e] + dt_bias[h]; const float sp = xx > 20.f ? xx : log1pf(__expf(xx)); o[e] = -__expf(A_log[h]) * sp; } }
                            *(f32x4*)(bg + (size_t)r * 16 + 8 * fq + 4 * n) = o; } }
            }
            return;
        }
        const int row0 = row0t + wr * 64 + fr; bf16_t* base; int ldc, colt;
        if (u.pn < 12) { base = qkv; ldc = CONVCH; colt = u.pn * BM; } else { base = zb; ldc = D; colt = (u.pn - 12) * BM; }
        const int col0 = colt + wc * 32 + 8 * fq;
#pragma unroll
        for (int ai = 0; ai < 2; ++ai)
#pragma unroll
            for (int m = 0; m < 4; ++m) { bf16_t* rowp = base + (size_t)(row0 + ai * HALF + m * 16) * ldc + col0;
#pragma unroll
                for (int bj = 0; bj < 2; ++bj) { const f32x4 v0 = acc[ai][bj][m][0], v1 = acc[ai][bj][m][1];
                    u32x4 w; w.x = cvt_pk_bf16(v0[0], v0[1]); w.y = cvt_pk_bf16(v0[2], v0[3]); w.z = cvt_pk_bf16(v1[0], v1[1]); w.w = cvt_pk_bf16(v1[2], v1[3]);
                    *(u32x4*)(rowp + bj * HALF) = w; } }
    }
};
template <bool FIRST> struct EpiRes {
    static constexpr bool PERM = true;
    const float* xp; const float* xs; const float* meta; bf16_t* xb; float* rss;
    __device__ __forceinline__ void operator()(f32x4 (&acc)[2][2][4][2], const Unit& u, int row0t, int wr, int wc, int fr, int fq) const {
        const int row0 = row0t + wr * 64 + fr, col0 = u.pn * BM + wc * 32 + 8 * fq;
#pragma unroll
        for (int ai = 0; ai < 2; ++ai) { if (ai == 1 && u.q != 0) break;
#pragma unroll
            for (int m = 0; m < 4; ++m) { const int r = row0 + ai * HALF + m * 16; bf16_t* rowp = xb + (size_t)r * D + col0;
                const float* src = FIRST ? x0_row(xp, xs, meta, r) : nullptr; float ss = 0.f;
#pragma unroll
                for (int bj = 0; bj < 2; ++bj) { f32x4 b0 = (f32x4){0.f, 0.f, 0.f, 0.f}, b1 = b0;
                    if (FIRST) { if (src) { b0 = *(const f32x4*)(src + col0 + bj * HALF); b1 = *(const f32x4*)(src + col0 + bj * HALF + 4); } }
                    else { const u32x4 w = *(const u32x4*)(rowp + bj * HALF);
                        b0 = (f32x4){__uint_as_float(w.x << 16), __uint_as_float(w.x & 0xffff0000u), __uint_as_float(w.y << 16), __uint_as_float(w.y & 0xffff0000u)};
                        b1 = (f32x4){__uint_as_float(w.z << 16), __uint_as_float(w.z & 0xffff0000u), __uint_as_float(w.w << 16), __uint_as_float(w.w & 0xffff0000u)}; }
                    const f32x4 v0 = acc[ai][bj][m][0] + b0, v1 = acc[ai][bj][m][1] + b1;
                    ss += ((v0[0] * v0[0] + v0[1] * v0[1]) + (v0[2] * v0[2] + v0[3] * v0[3])) + ((v1[0] * v1[0] + v1[1] * v1[1]) + (v1[2] * v1[2] + v1[3] * v1[3]));
                    u32x4 o; o.x = cvt_pk_bf16(v0[0], v0[1]); o.y = cvt_pk_bf16(v0[2], v0[3]); o.z = cvt_pk_bf16(v1[0], v1[1]); o.w = cvt_pk_bf16(v1[2], v1[3]);
                    *(u32x4*)(rowp + bj * HALF) = o; }
                if (rss) { ss += __shfl_xor(ss, 16); ss += __shfl_xor(ss, 32); if (fq == 0) atomicAdd(rss + r, ss); }
                if (m & 1) asm volatile("" ::: "memory"); } }
    }
};
template <bool SAMPLE> struct EpiFFNUp {
    static constexpr bool PERM = true;
    bf16_t* act; const float* cw; const float* cb; const float* st; float* outp; float* outs; LAS float* bnd; const float* rss;
    __device__ __forceinline__ void prescale_publish(f32x4 (&acc)[2][2][4][2], const float (&rs)[2][4], int wr, int wc, int fr, int fq) const {
#pragma unroll
        for (int ai = 0; ai < 2; ++ai)
#pragma unroll
            for (int m = 0; m < 4; ++m) { const float r1 = rsqrtf(rs[ai][m] * (1.f / D) + EPS);
#pragma unroll
                for (int bj = 0; bj < 2; ++bj)
#pragma unroll
                    for (int n = 0; n < 2; ++n) acc[ai][bj][m][n] = acc[ai][bj][m][n] * r1; }
        if (fr >= 14) {
#pragma unroll
            for (int ai = 0; ai < 2; ++ai)
#pragma unroll
                for (int bj = 0; bj < 2; ++bj)
#pragma unroll
                    for (int n = 0; n < 2; ++n) *(LAS f32x4*)(bnd + ((ai * 2 + wr) * 2 + (fr - 14)) * 256 + bj * 128 + wc * 32 + 8 * fq + 4 * n) = acc[ai][bj][3][n];
        }
        asm volatile("s_waitcnt lgkmcnt(0)" ::: "memory"); __builtin_amdgcn_s_barrier(); asm volatile("" ::: "memory");
    }
    template <int M_> __device__ __forceinline__ f32x4 conv4(const f32x4 c4, const f32x4 pg, const LAS float* bp, int fr, const f32x4 w0, const f32x4 w1, const f32x4 w2, const f32x4 bsv, int db) const {
        f32x4 p1, p2;
        if (M_ > 0) {
#pragma unroll
            for (int e = 0; e < 4; ++e) { p1[e] = dpp_f<0x111>(dpp_r<0x121>(pg[e]), c4[e]); p2[e] = dpp_f<0x112>(dpp_r<0x122>(pg[e]), c4[e]); }
        } else {
            const f32x4 x1 = *(const LAS f32x4*)(bp + 256), x2 = *(const LAS f32x4*)(bp + (fr & 1) * 256);
#pragma unroll
            for (int e = 0; e < 4; ++e) { p1[e] = dpp_f<0x111>(x1[e], c4[e]); p2[e] = dpp_f<0x112>(x2[e], c4[e]); }
        }
        if ((unsigned)(db + 1) < 17u) { const int d = fr - db;
#pragma unroll
            for (int e = 0; e < 4; ++e) { p1[e] = d == 0 ? 0.f : p1[e]; p2[e] = (unsigned)d < 2u ? 0.f : p2[e]; } }
        f32x4 uu = bsv + w2 * c4 + w1 * p1 + w0 * p2;
        asm volatile("" : "+v"(uu));
        return uu;
    }
    __device__ __forceinline__ void prompt(f32x4 (&acc)[2][2][4][2], const Unit& u, int row0t, int wr, int wc, int fr, int fq) const {
        const int q0 = row0t / LP, rem0 = row0t - q0 * LP;
        const int rho_b = rem0 < 2 ? -rem0 : LP - rem0;
        const int lo = u.pm == 0 ? 0 : 2;
        const unsigned rowoff0 = (unsigned)(row0t + wr * 64 + fr) * (unsigned)(DFF * 2);
        int cl = wc * 32 + 8 * fq; asm volatile("" : "+v"(cl));
        const int ca = u.pn * 128 + cl;
        if (rho_b >= lo + 1 && rho_b <= 257) {
#pragma unroll
            for (int ai = 0; ai < 2; ++ai)
#pragma unroll
                for (int m = 0; m < 4; ++m) { const int g0 = ai * HALF + wr * 64 + m * 16, d0 = rho_b - 2 - g0;
                    if (d0 >= -1 && d0 <= 15) { const int tl = fr - d0;
                        if ((unsigned)tl < 2u && g0 + fr >= lo) { float* op = outp + ((size_t)q0 * 2 + tl) * DFF2 + ca;
#pragma unroll
                            for (int bj = 0; bj < 2; ++bj)
#pragma unroll
                                for (int n = 0; n < 2; ++n) *(f32x4*)(op + bj * DFF + 4 * n) = acc[ai][bj][m][n]; } } }
        }
#pragma unroll
        for (int n = 0; n < 2; ++n) {
            const unsigned cso = (unsigned)((ca + 4 * n) * 4);
            const f32x4 w0 = *(const f32x4*)((const char*)cw + cso), w1 = *(const f32x4*)((const char*)(cw + DFF2) + cso), w2 = *(const f32x4*)((const char*)(cw + 2 * DFF2) + cso), bsv = *(const f32x4*)((const char*)cb + cso);
#pragma unroll
            for (int ai = 0; ai < 2; ++ai) {
                int ps = ai * 2 + wr - 1; ps = ps < 0 ? 0 : ps;
                const LAS float* bp = bnd + (ps * 2) * 256 + cl + 4 * n;
                const int db0 = rho_b - (ai * HALF + wr * 64);
                acc[ai][0][3][n] = conv4<3>(acc[ai][0][3][n], acc[ai][0][2][n], bp, fr, w0, w1, w2, bsv, db0 - 48);
                acc[ai][0][2][n] = conv4<2>(acc[ai][0][2][n], acc[ai][0][1][n], bp, fr, w0, w1, w2, bsv, db0 - 32);
                acc[ai][0][1][n] = conv4<1>(acc[ai][0][1][n], acc[ai][0][0][n], bp, fr, w0, w1, w2, bsv, db0 - 16);
                acc[ai][0][0][n] = conv4<0>(acc[ai][0][0][n], acc[ai][0][0][n], bp, fr, w0, w1, w2, bsv, db0);
            }
        }
        asm volatile("" ::: "memory");
        f32x4 wk[4];
        u32x2 pend[4];
#pragma unroll
        for (int step = 0; step < 4; ++step) {
            const int n = (step == 1 || step == 2) ? 1 : 0, ai = step >> 1;
            f32x4 w0, w1, w2, bsv;
            if (step != 2) { const unsigned cso = (unsigned)((DFF + ca + 4 * n) * 4);
                w0 = *(const f32x4*)((const char*)cw + cso); w1 = *(const f32x4*)((const char*)(cw + DFF2) + cso); w2 = *(const f32x4*)((const char*)(cw + 2 * DFF2) + cso); bsv = *(const f32x4*)((const char*)cb + cso);
                wk[0] = w0; wk[1] = w1; wk[2] = w2; wk[3] = bsv; }
            else { w0 = wk[0]; w1 = wk[1]; w2 = wk[2]; bsv = wk[3]; }
            int ps = ai * 2 + wr - 1; ps = ps < 0 ? 0 : ps;
            const LAS float* bp = bnd + (ps * 2) * 256 + 128 + cl + 4 * n;
            const int db0 = rho_b - (ai * HALF + wr * 64);
#define FFN_GATE_STORE(M_) do { \
                const f32x4 uu = conv4<M_>(acc[ai][1][M_][n], acc[ai][1][M_ > 0 ? M_ - 1 : 0][n], bp, fr, w0, w1, w2, bsv, db0 - 16 * M_); \
                const f32x4 ua = acc[ai][0][M_][n]; \
                u32x2 w; w.x = cvt_pk_bf16(silu_f(ua[0]) * uu[0], silu_f(ua[1]) * uu[1]); w.y = cvt_pk_bf16(silu_f(ua[2]) * uu[2], silu_f(ua[3]) * uu[3]); \
                if ((step & 1) == 0) pend[M_] = w; \
                else { u32x4 o; if (n == 1) { o.x = pend[M_].x; o.y = pend[M_].y; o.z = w.x; o.w = w.y; } else { o.x = w.x; o.y = w.y; o.z = pend[M_].x; o.w = pend[M_].y; } \
                    const unsigned off = rowoff0 + (unsigned)((ai * HALF + M_ * 16) * DFF * 2) + (unsigned)(ca * 2); \
                    if (ai == 0 && M_ == 0) { if (wr != 0 || fr >= lo) *(u32x4*)((char*)act + off) = o; } \
                    else *(u32x4*)((char*)act + off) = o; } \
                __builtin_amdgcn_sched_barrier(0); } while (0)
            FFN_GATE_STORE(3); FFN_GATE_STORE(2); FFN_GATE_STORE(1); FFN_GATE_STORE(0);
#undef FFN_GATE_STORE
        }
    }
    __device__ __forceinline__ f32x4 conv4s(const f32x4 c4, const f32x4 pv, int t, const f32x4 w0, const f32x4 w1, const f32x4 w2, const f32x4 bsv) const {
        f32x4 p1, p2;
#pragma unroll
        for (int e = 0; e < 4; ++e) { p1[e] = dpp_f<0x111>(0.f, c4[e]); p2[e] = dpp_f<0x112>(0.f, c4[e]); const float q1 = dpp_f<0x101>(0.f, pv[e]);
            p1[e] = t == 0 ? q1 : p1[e]; p2[e] = t < 2 ? pv[e] : p2[e]; }
        f32x4 uu = bsv + w2 * c4 + w1 * p1 + w0 * p2;
        asm volatile("" : "+v"(uu));
        return uu;
    }
    __device__ __forceinline__ void sample(f32x4 (&acc)[2][2][4][2], const Unit& u, int row0t, int wr, int wc, int fr, int fq) const {
        const int t = fr & 7, sql = ((row0t - NPROMPT + wr * 64) >> 3) + (fr >> 3);
        const unsigned rowoff0 = (unsigned)(row0t + wr * 64 + fr) * (unsigned)(DFF * 2);
        int cl = wc * 32 + 8 * fq; asm volatile("" : "+v"(cl));
        const int ca = u.pn * 128 + cl;
        if (t >= DECS - 2) {
#pragma unroll
            for (int ai = 0; ai < 2; ++ai)
#pragma unroll
                for (int m = 0; m < 4; ++m) { const unsigned oo = (unsigned)(((sql + 16 * ai + 2 * m) * 2 + (t - (DECS - 2))) * DFF2 + ca) * 4u;
#pragma unroll
                    for (int bj = 0; bj < 2; ++bj)
#pragma unroll
                        for (int n = 0; n < 2; ++n) *(f32x4*)((char*)outs + oo + (unsigned)((bj * DFF + 4 * n) * 4)) = acc[ai][bj][m][n]; }
            asm volatile("" ::: "memory");
        }
        const unsigned stoff = (unsigned)((sql * 2 + (t & 1)) * DFF2 + ca) * 4u;
#pragma unroll
        for (int n = 0; n < 2; ++n) {
            const unsigned cso = (unsigned)((ca + 4 * n) * 4);
            const f32x4 w0 = *(const f32x4*)((const char*)cw + cso), w1 = *(const f32x4*)((const char*)(cw + DFF2) + cso), w2 = *(const f32x4*)((const char*)(cw + 2 * DFF2) + cso), bsv = *(const f32x4*)((const char*)cb + cso);
#pragma unroll
            for (int ai = 0; ai < 2; ++ai) {
#pragma unroll
                for (int mp = 0; mp < 4; mp += 2) {
                    f32x4 pv[2];
#pragma unroll
                    for (int k = 0; k < 2; ++k) { pv[k] = (f32x4){0.f, 0.f, 0.f, 0.f}; if (t < 2) pv[k] = *(const f32x4*)((const char*)st + stoff + (unsigned)(((16 * ai + 2 * (mp + k)) * 2 * DFF2 + 4 * n) * 4)); }
#pragma unroll
                    for (int k = 0; k < 2; ++k) acc[ai][0][mp + k][n] = conv4s(acc[ai][0][mp + k][n], pv[k], t, w0, w1, w2, bsv);
                    __builtin_amdgcn_sched_barrier(0);
                }
            }
        }
        asm volatile("" ::: "memory");
        f32x4 wk[4];
        u32x2 pend[4];
#pragma unroll
        for (int step = 0; step < 4; ++step) {
            const int n = (step == 1 || step == 2) ? 1 : 0, ai = step >> 1;
            f32x4 w0, w1, w2, bsv;
            if (step != 2) { const unsigned cso = (unsigned)((DFF + ca + 4 * n) * 4);
                w0 = *(const f32x4*)((const char*)cw + cso); w1 = *(const f32x4*)((const char*)(cw + DFF2) + cso); w2 = *(const f32x4*)((const char*)(cw + 2 * DFF2) + cso); bsv = *(const f32x4*)((const char*)cb + cso);
                wk[0] = w0; wk[1] = w1; wk[2] = w2; wk[3] = bsv; }
            else { w0 = wk[0]; w1 = wk[1]; w2 = wk[2]; bsv = wk[3]; }
#pragma unroll
            for (int mp = 0; mp < 4; mp += 2) {
            f32x4 pv[2];
#pragma unroll
            for (int k = 0; k < 2; ++k) { pv[k] = (f32x4){0.f, 0.f, 0.f, 0.f}; if (t < 2) pv[k] = *(const f32x4*)((const char*)st + stoff + (unsigned)(((16 * ai + 2 * (mp + k)) * 2 * DFF2 + DFF + 4 * n) * 4)); }
#pragma unroll
            for (int k = 0; k < 2; ++k) { const int m = mp + k;
                const f32x4 uu = conv4s(acc[ai][1][m][n], pv[k], t, w0, w1, w2, bsv);
                const f32x4 ua = acc[ai][0][m][n];
                u32x2 w; w.x = cvt_pk_bf16(silu_f(ua[0]) * uu[0], silu_f(ua[1]) * uu[1]); w.y = cvt_pk_bf16(silu_f(ua[2]) * uu[2], silu_f(ua[3]) * uu[3]);
                if ((step & 1) == 0) pend[m] = w;
                else { u32x4 o; if (n == 1) { o.x = pend[m].x; o.y = pend[m].y; o.z = w.x; o.w = w.y; } else { o.x = w.x; o.y = w.y; o.z = pend[m].x; o.w = pend[m].y; }
                    *(u32x4*)((char*)act + rowoff0 + (unsigned)((ai * HALF + m * 16) * DFF * 2) + (unsigned)(ca * 2)) = o; }
                __builtin_amdgcn_sched_barrier(0);
            }
            }
        }
    }
    __device__ __forceinline__ void operator()(f32x4 (&acc)[2][2][4][2], const Unit& u, int row0t, int wr, int wc, int fr, int fq) const {
        asm volatile("" : "+v"(fr), "+v"(fq));
        {
            float rs[2][4];
#pragma unroll
            for (int ai = 0; ai < 2; ++ai)
#pragma unroll
                for (int m = 0; m < 4; ++m) rs[ai][m] = rss[row0t + ai * HALF + wr * 64 + m * 16 + fr];
            prescale_publish(acc, rs, wr, wc, fr, fq);
        }
        if constexpr (!SAMPLE) prompt(acc, u, row0t, wr, wc, fr, fq); else sample(acc, u, row0t, wr, wc, fr, fq);
    }
};
}


#define MFMA16(a, b, c) __builtin_amdgcn_mfma_f32_16x16x32_bf16(a, b, c, 0, 0, 0)
constexpr int NCHUNK = 33, NITEM_P = BATCH * NCHUNK * NH  , REC_BYTES = 73728;
constexpr int REC_WN = 0, REC_QD = 16384, REC_KDT = 32768, REC_AM = 49152, REC_U = 57344, REC_DMA = 57344;
__device__ __forceinline__ float row16_sum(float v) {
    v += dpp_f<0xB1>(0.f, v); v += dpp_f<0x4E>(0.f, v); v += dpp_f<0x124>(0.f, v); v += dpp_f<0x128>(0.f, v); return v;
}
__device__ __forceinline__ bf16x8 pack8(const f32x4 a, const f32x4 b) {
    u32x4 w; w.x = cvt_pk_bf16(a[0], a[1]); w.y = cvt_pk_bf16(a[2], a[3]); w.z = cvt_pk_bf16(b[0], b[1]); w.w = cvt_pk_bf16(b[2], b[3]); return __builtin_bit_cast(bf16x8, w);
}
constexpr int P2_QN = 0, P2_KN = 17408, P2_VBT = 34816, P2_KBT = 53248, P2_LF = 71680, P2_TF = 89088, P2_TB = 106496, P2_XS = 115712, P2_G = 118784, LS = 68;

struct PrepRaw { u32x4 x[2][5]; float gi, be; };
__device__ __forceinline__ void gdn_prep_load(PrepRaw& R, int item, int b0, const bf16_t* qkv, const float* bg, int tid) {
    const int h = item & 7, c = (item >> 3) % NCHUNK, b = b0 + (item >> 3) / NCHUNK;
    const int tbase = 64 * c - 48, cc = tid & 15, i0 = (tid >> 4) * 2;
#pragma unroll
    for (int part = 0; part < 2; ++part)
#pragma unroll
        for (int j = 0; j < 5; ++j) { const int t = tbase + i0 - 3 + j;
            R.x[part][j] = (t >= 0) ? *(const u32x4*)(qkv + (size_t)(b * LP + t) * CONVCH + part * 1024 + h * 128 + 8 * cc) : (u32x4){0u, 0u, 0u, 0u}; }
    R.gi = 0.f; R.be = 0.f;
    if (tid < 64) { const int t = tbase + tid; if (t >= 0) { const float* p = bg + (size_t)(b * LP + t) * 16; R.gi = p[8 + h]; R.be = p[h]; } }
}
__device__ __forceinline__ void gdn_prep_item(LAS unsigned char* lds, int item, int b0, PrepRaw& R, int next_item, const bf16_t* qkv, const float* bg, const float* gconv_w, unsigned char* rec, float* gtarr) {
    const int tid = fresh_tid(), lane = tid & 63, wave = __builtin_amdgcn_readfirstlane(tid >> 6), g = lane >> 4, l15 = lane & 15;
    const int h = item & 7;
    LAS float* Gs = (LAS float*)(lds + P2_G); LAS float* Bs = Gs + 64; LAS float* EG = Gs + 128; LAS float* DKs = Gs + 192;
    LAS float* Lf = (LAS float*)(lds + P2_LF); LAS float* Tf = (LAS float*)(lds + P2_TF); LAS float* Xs = (LAS float*)(lds + P2_XS);
    u32x4 xv[5];
    { const int c = (item >> 3) % NCHUNK, b = b0 + (item >> 3) / NCHUNK, tbase = 64 * c - 48, cc = tid & 15, i0 = (tid >> 4) * 2;
#pragma unroll
      for (int j = 0; j < 5; ++j) { const int t = tbase + i0 - 3 + j; xv[j] = (t >= 0) ? *(const u32x4*)(qkv + (size_t)(b * LP + t) * CONVCH + 2048 + h * 128 + 8 * cc) : (u32x4){0u, 0u, 0u, 0u}; } }
    if (wave == 0) {
        float G = R.gi;
#pragma unroll
        for (int o = 1; o < 64; o <<= 1) { const float v = __shfl_up(G, o); if (lane >= o) G += v; }
        const float Gl = __shfl(G, 63);
        Gs[lane] = G; Bs[lane] = R.be; EG[lane] = __expf(G); DKs[lane] = __expf(Gl - G);
        if (lane == 0) gtarr[item] = __expf(Gl);
    }
    for (int i = tid; i < 64 * LS; i += NTHREADS) Tf[i] = 0.f;
    __syncthreads();
    {
        const int cc = tid & 15, i0 = (tid >> 4) * 2;
        const float be0 = Bs[i0], be1 = Bs[i0 + 1], eg0 = EG[i0], eg1 = EG[i0 + 1];
#pragma unroll
        for (int part = 0; part < 3; ++part) {
            const int col = part * 1024 + h * 128 + 8 * cc;
            float y0[8], y1[8];
#pragma unroll
            for (int e = 0; e < 8; ++e) { y0[e] = 0.f; y1[e] = 0.f; }
#pragma unroll
            for (int j = 0; j < 5; ++j) { const u32x4 v = part < 2 ? R.x[part < 2 ? part : 0][j] : xv[j]; const unsigned vv[4] = {v.x, v.y, v.z, v.w}; float x[8];
#pragma unroll
                for (int e = 0; e < 4; ++e) { x[2 * e] = __uint_as_float(vv[e] << 16); x[2 * e + 1] = __uint_as_float(vv[e] & 0xffff0000u); }
                if (j < 4) { const f32x4 wa = *(const f32x4*)(gconv_w + j * CONVCH + col), wb = *(const f32x4*)(gconv_w + j * CONVCH + col + 4);
#pragma unroll
                    for (int e = 0; e < 8; ++e) y0[e] += (e < 4 ? wa[e] : wb[e - 4]) * x[e]; }
                if (j > 0) { const f32x4 wa = *(const f32x4*)(gconv_w + (j - 1) * CONVCH + col), wb = *(const f32x4*)(gconv_w + (j - 1) * CONVCH + col + 4);
#pragma unroll
                    for (int e = 0; e < 8; ++e) y1[e] += (e < 4 ? wa[e] : wb[e - 4]) * x[e]; } }
            float s0 = 0.f, s1 = 0.f;
#pragma unroll
            for (int e = 0; e < 8; ++e) { y0[e] = silu_f(y0[e]); y1[e] = silu_f(y1[e]); s0 += y0[e] * y0[e]; s1 += y1[e] * y1[e]; }
            if (part < 2) {
                s0 = row16_sum(s0); s1 = row16_sum(s1);
                float sc0 = rsqrtf(s0 + EPS), sc1 = rsqrtf(s1 + EPS); if (part == 0) { sc0 *= 0.08838834764831845f; sc1 *= 0.08838834764831845f; }
#pragma unroll
                for (int e = 0; e < 8; ++e) { y0[e] *= sc0; y1[e] *= sc1; }
                LAS unsigned char* img = lds + (part == 0 ? P2_QN : P2_KN);
                u32x4 w0, w1; w0.x = cvt_pk_bf16(y0[0], y0[1]); w0.y = cvt_pk_bf16(y0[2], y0[3]); w0.z = cvt_pk_bf16(y0[4], y0[5]); w0.w = cvt_pk_bf16(y0[6], y0[7]);
                w1.x = cvt_pk_bf16(y1[0], y1[1]); w1.y = cvt_pk_bf16(y1[2], y1[3]); w1.z = cvt_pk_bf16(y1[4], y1[5]); w1.w = cvt_pk_bf16(y1[6], y1[7]);
                *(LAS u32x4*)(img + (i0 * 136 + 8 * cc) * 2) = w0; *(LAS u32x4*)(img + ((i0 + 1) * 136 + 8 * cc) * 2) = w1;
                if (part == 1) {
                    const float f0 = be0 * eg0, f1 = be1 * eg1;
#pragma unroll
                    for (int e = 0; e < 8; ++e) *(LAS unsigned*)(lds + P2_KBT + ((8 * cc + e) * 72 + i0) * 2) = cvt_pk_bf16(y0[e] * f0, y1[e] * f1);
                }
            } else {
#pragma unroll
                for (int e = 0; e < 8; ++e) *(LAS unsigned*)(lds + P2_VBT + ((8 * cc + e) * 72 + i0) * 2) = cvt_pk_bf16(y0[e] * be0, y1[e] * be1);
            }
            __builtin_amdgcn_sched_barrier(0);
        }
    }
    if (next_item >= 0) gdn_prep_load(R, next_item, b0, qkv, bg, tid);
    __syncthreads();
    {
        const f32x4 z4 = (f32x4){0.f, 0.f, 0.f, 0.f};
        {
            const int ta = wave >> 1;
#pragma unroll
            for (int q = 0; q < 2; ++q) { const int tb = 2 * (wave & 1) + q; f32x4 acc = z4;
#pragma unroll
                for (int s = 0; s < 4; ++s) { const bf16x8 af = *(const LAS bf16x8*)(lds + P2_KN + ((16 * ta + l15) * 136 + 32 * s + 8 * g) * 2), bfr = *(const LAS bf16x8*)(lds + P2_KN + ((16 * tb + l15) * 136 + 32 * s + 8 * g) * 2);
                    acc = MFMA16(af, bfr, acc); }
                const int j = 16 * tb + l15; const float Gj = Gs[j];
#pragma unroll
                for (int r = 0; r < 4; ++r) { const int i = 16 * ta + 4 * g + r; Lf[i * LS + j] = (i > j) ? Bs[i] * acc[r] * __expf(Gs[i] - Gj) : 0.f; } }
        }
        {
            const int rt = wave >> 1, s = wave & 1; f32x4 a0 = z4, a1 = z4;
#pragma unroll
            for (int ks = 0; ks < 4; ++ks) { const bf16x8 qf = *(const LAS bf16x8*)(lds + P2_QN + ((16 * rt + l15) * 136 + 32 * ks + 8 * g) * 2);
                const bf16x8 k0 = *(const LAS bf16x8*)(lds + P2_KN + ((32 * s + l15) * 136 + 32 * ks + 8 * g) * 2), k1 = *(const LAS bf16x8*)(lds + P2_KN + ((32 * s + 16 + l15) * 136 + 32 * ks + 8 * g) * 2);
                a0 = MFMA16(k0, qf, a0); a1 = MFMA16(k1, qf, a1); }
            const int i = 16 * rt + l15; const float Gi = Gs[i];
#pragma unroll
            for (int r = 0; r < 4; ++r) { const int ia = 32 * s + 4 * g + r, ib = ia + 16;
                a0[r] = (i >= ia) ? a0[r] * __expf(Gi - Gs[ia]) : 0.f; a1[r] = (i >= ib) ? a1[r] * __expf(Gi - Gs[ib]) : 0.f; }
            *(bf16x8*)(rec + REC_AM + ((rt * 2 + s) * 64 + lane) * 16) = pack8(a0, a1);
        }
    }
    __syncthreads();
    if (tid < 64) { const int blk = tid >> 4, cidx = tid & 15; float x[16];
#pragma unroll
        for (int i = 0; i < 16; ++i) x[i] = (i == cidx) ? 1.f : 0.f;
#pragma unroll
        for (int i = 1; i < 16; ++i) { float a = 0.f; const LAS float* row = Lf + (16 * blk + i) * LS + 16 * blk;
#pragma unroll
            for (int j4 = 0; j4 < (i + 3) / 4; ++j4) { const f32x4 l4 = *(const LAS f32x4*)(row + 4 * j4);
#pragma unroll
                for (int e = 0; e < 4; ++e) if (4 * j4 + e < i) a += l4[e] * x[4 * j4 + e]; }
            if (i > cidx) x[i] = -a; }
#pragma unroll
        for (int i = 0; i < 16; ++i) Tf[(16 * blk + i) * LS + 16 * blk + cidx] = x[i];
    }
    __syncthreads();
#pragma unroll 1
    for (int k = 1; k < 4; ++k) {
        const int ntask = (4 - k) * 64;
        if (tid < ntask) { const int bi = tid >> 6, r = (tid >> 2) & 15, cq = tid & 3, a = bi + k; f32x4 X = (f32x4){0.f, 0.f, 0.f, 0.f};
            for (int m = bi; m < a; ++m)
#pragma unroll
                for (int j4 = 0; j4 < 4; ++j4) { const f32x4 l4 = *(const LAS f32x4*)(Lf + (16 * a + r) * LS + 16 * m + 4 * j4);
#pragma unroll
                    for (int e = 0; e < 4; ++e) X += l4[e] * *(const LAS f32x4*)(Tf + (16 * m + 4 * j4 + e) * LS + 16 * bi + 4 * cq); }
            *(LAS f32x4*)(Xs + bi * 256 + r * 16 + 4 * cq) = X; }
        __syncthreads();
        if (tid < ntask) { const int bi = tid >> 6, r = (tid >> 2) & 15, cq = tid & 3, a = bi + k; f32x4 v = (f32x4){0.f, 0.f, 0.f, 0.f};
#pragma unroll
            for (int j4 = 0; j4 < 4; ++j4) { const f32x4 t4 = *(const LAS f32x4*)(Tf + (16 * a + r) * LS + 16 * a + 4 * j4);
#pragma unroll
                for (int e = 0; e < 4; ++e) v += t4[e] * *(const LAS f32x4*)(Xs + bi * 256 + (4 * j4 + e) * 16 + 4 * cq); }
            *(LAS f32x4*)(Tf + (16 * a + r) * LS + 16 * bi + 4 * cq) = -v; }
        __syncthreads();
    }
    for (int i = tid; i < 64 * 16; i += NTHREADS) { const int r = i >> 4, c4 = (i & 15) * 4; const f32x4 t4 = *(const LAS f32x4*)(Tf + r * LS + c4);
        u32x2 w; w.x = cvt_pk_bf16(t4[0], t4[1]); w.y = cvt_pk_bf16(t4[2], t4[3]); *(LAS u32x2*)(lds + P2_TB + (r * 72 + c4) * 2) = w; }
    __syncthreads();
    {
        const f32x4 z4 = (f32x4){0.f, 0.f, 0.f, 0.f};
#pragma unroll
        for (int rt = 0; rt < 4; ++rt) { f32x4 acc = z4;
#pragma unroll
            for (int s = 0; s < 2; ++s) { const bf16x8 tf = *(const LAS bf16x8*)(lds + P2_TB + ((16 * rt + l15) * 72 + 32 * s + 8 * g) * 2), vf = *(const LAS bf16x8*)(lds + P2_VBT + ((16 * wave + l15) * 72 + 32 * s + 8 * g) * 2);
                acc = MFMA16(tf, vf, acc); }
            u32x2 w; w.x = cvt_pk_bf16(acc[0], acc[1]); w.y = cvt_pk_bf16(acc[2], acc[3]);
            *(u32x2*)(rec + REC_U + ((rt * 8 + wave) * 64 + lane) * 8) = w; }
        const int rt = wave >> 1;
#pragma unroll
        for (int q = 0; q < 2; ++q) { const int s2 = 2 * (wave & 1) + q; f32x4 a0 = z4, a1 = z4;
#pragma unroll
            for (int s = 0; s < 2; ++s) { const bf16x8 tf = *(const LAS bf16x8*)(lds + P2_TB + ((16 * rt + l15) * 72 + 32 * s + 8 * g) * 2);
                const bf16x8 k0 = *(const LAS bf16x8*)(lds + P2_KBT + ((32 * s2 + l15) * 72 + 32 * s + 8 * g) * 2), k1 = *(const LAS bf16x8*)(lds + P2_KBT + ((32 * s2 + 16 + l15) * 72 + 32 * s + 8 * g) * 2);
                a0 = MFMA16(k0, tf, a0); a1 = MFMA16(k1, tf, a1); }
            *(bf16x8*)(rec + REC_WN + ((rt * 4 + s2) * 64 + lane) * 16) = pack8(-a0, -a1); }
    }
#pragma unroll
    for (int q = 0; q < 2; ++q) { const int task = tid + q * NTHREADS, fragi = task >> 6, ln = task & 63, lg = ln >> 4, l = ln & 15;
        const int rt = fragi >> 2, s2 = fragi & 3, i = 16 * rt + l; const float e = EG[i];
        const u32x2 lo = *(const LAS u32x2*)(lds + P2_QN + (i * 136 + 32 * s2 + 4 * lg) * 2), hi = *(const LAS u32x2*)(lds + P2_QN + (i * 136 + 32 * s2 + 16 + 4 * lg) * 2);
        const unsigned vv[4] = {lo.x, lo.y, hi.x, hi.y}; u32x4 w; unsigned ww[4];
#pragma unroll
        for (int k2 = 0; k2 < 4; ++k2) ww[k2] = cvt_pk_bf16(__uint_as_float(vv[k2] << 16) * e, __uint_as_float(vv[k2] & 0xffff0000u) * e);
        w.x = ww[0]; w.y = ww[1]; w.z = ww[2]; w.w = ww[3];
        *(u32x4*)(rec + REC_QD + (fragi * 64 + ln) * 16) = w; }
#pragma unroll
    for (int q = 0; q < 2; ++q) { const int task = tid + q * NTHREADS, fragi = task >> 6, ln = task & 63, lg = ln >> 4, l = ln & 15;
        const int dt = fragi >> 1, s = fragi & 1, dk = 16 * dt + l; float v[8];
#pragma unroll
        for (int j = 0; j < 8; ++j) { const int i = 32 * s + 4 * lg + (j & 3) + 16 * (j >> 2); v[j] = bf2f(*(const LAS bf16_t*)(lds + P2_KN + (i * 136 + dk) * 2)) * DKs[i]; }
        u32x4 w; w.x = cvt_pk_bf16(v[0], v[1]); w.y = cvt_pk_bf16(v[2], v[3]); w.z = cvt_pk_bf16(v[4], v[5]); w.w = cvt_pk_bf16(v[6], v[7]);
        *(u32x4*)(rec + REC_KDT + (fragi * 64 + ln) * 16) = w; }
    __syncthreads();
}

constexpr int P3_BUF = 0, P3_OST = 114688, P3_OSTB = 16896, P3_RSS = 148480, P3_RSSB = 2048, P3_NW = 152576;
static_assert(P3_NW + 512 <= LDS_MISC, "scan LDS map");
__device__ __forceinline__ void gdn_scan_finalize(LAS unsigned char* lds, int cf, int b, int h, int tid, const u32x4 z0, const u32x4 z1, bf16_t* zb, const float* gnorm_w) {
    const int i = tid >> 3, seg = tid & 7, t = 64 * cf - 48 + i;
    LAS unsigned char* ost = lds + P3_OST + (cf & 1) * P3_OSTB;
    const u32x2 o0 = *(const LAS u32x2*)(ost + (i * 132 + 16 * seg) * 2), o1 = *(const LAS u32x2*)(ost + (i * 132 + 16 * seg + 4) * 2),
                o2 = *(const LAS u32x2*)(ost + (i * 132 + 16 * seg + 8) * 2), o3 = *(const LAS u32x2*)(ost + (i * 132 + 16 * seg + 12) * 2);
    const unsigned oo[8] = {o0.x, o0.y, o1.x, o1.y, o2.x, o2.y, o3.x, o3.y};
    float of[16]; float ss = 0.f;
#pragma unroll
    for (int k2 = 0; k2 < 8; ++k2) { of[2 * k2] = __uint_as_float(oo[k2] << 16); of[2 * k2 + 1] = __uint_as_float(oo[k2] & 0xffff0000u); ss += of[2 * k2] * of[2 * k2] + of[2 * k2 + 1] * of[2 * k2 + 1]; }
    ss += dpp_f<0xB1>(0.f, ss); ss += dpp_f<0x4E>(0.f, ss); ss += __shfl_xor(ss, 4);
    if (t >= 0) {
        const float rstd = rsqrtf(ss * (1.f / DV) + EPS);
        bf16_t* zr = zb + (size_t)(b * LP + t) * D + h * 128 + 16 * seg;
        const unsigned zz[8] = {z0.x, z0.y, z0.z, z0.w, z1.x, z1.y, z1.z, z1.w};
        const LAS float* nw = (const LAS float*)(lds + P3_NW) + 16 * seg; unsigned res[8];
#pragma unroll
        for (int k2 = 0; k2 < 8; ++k2) { const float za = __uint_as_float(zz[k2] << 16), zc = __uint_as_float(zz[k2] & 0xffff0000u);
            res[k2] = cvt_pk_bf16(of[2 * k2] * rstd * nw[2 * k2] * silu_f(za), of[2 * k2 + 1] * rstd * nw[2 * k2 + 1] * silu_f(zc)); }
        *(u32x4*)zr = (u32x4){res[0], res[1], res[2], res[3]}; *(u32x4*)(zr + 8) = (u32x4){res[4], res[5], res[6], res[7]};
    }
}
template <class RecFn>
__device__ __forceinline__ void gdn_scan(LAS unsigned char* lds, int bh, int b0, RecFn rec_of, const float* gtarr, bf16_t* zb, const float* gnorm_w, float* Sout) {
    const int tid = fresh_tid(), lane = tid & 63, wave = __builtin_amdgcn_readfirstlane(tid >> 6), g = lane >> 4, l15 = lane & 15;
    const int b = bh >> 3, h = bh & 7, bl = b - b0;
    const f32x4 z4 = (f32x4){0.f, 0.f, 0.f, 0.f};
    const u32x4 zu = (u32x4){0u, 0u, 0u, 0u};
    f32x4 S[8];
#pragma unroll
    for (int dt = 0; dt < 8; ++dt) S[dt] = z4;
    u32x2 Un[4]; float gtn; u32x4 zn0 = zu, zn1 = zu, zp0 = zu, zp1 = zu;
    const int zi = tid >> 3, zseg = tid & 7;
    if (tid < DV) ((LAS float*)(lds + P3_NW))[tid] = gnorm_w[tid];
    {
        const unsigned char* rec = rec_of((bl * NCHUNK + 0) * 8 + h);
#pragma unroll
        for (int pz = 0; pz < 7; ++pz) { const int piece = wave + 8 * pz; __builtin_amdgcn_global_load_lds((const unsigned*)(rec + piece * 1024 + lane * 16), (LAS unsigned*)(lds + P3_BUF + piece * 1024), 16, 0, 0); }
#pragma unroll
        for (int rt = 0; rt < 4; ++rt) Un[rt] = *(const u32x2*)(rec + REC_U + ((rt * 8 + wave) * 64 + lane) * 8);
        gtn = gtarr[(bl * NCHUNK + 0) * 8 + h];
        { const int t = -48 + zi; if (t >= 0) { const bf16_t* zr = zb + (size_t)(b * LP + t) * D + h * 128 + 16 * zseg; zn0 = *(const u32x4*)zr; zn1 = *(const u32x4*)(zr + 8); } }
    }
    asm volatile("s_waitcnt vmcnt(0)" ::: "memory");
    __syncthreads();
#pragma unroll 1
    for (int c = 0; c < NCHUNK; ++c) {
        LAS unsigned char* buf = lds + P3_BUF + (c & 1) * REC_DMA;
        u32x2 Uc[4];
#pragma unroll
        for (int rt = 0; rt < 4; ++rt) Uc[rt] = Un[rt];
        const float gt = gtn;
        const u32x4 zf0 = zp0, zf1 = zp1;
        zp0 = zn0; zp1 = zn1;
        if (c + 1 < NCHUNK) {
            const unsigned char* rec = rec_of((bl * NCHUNK + c + 1) * 8 + h); LAS unsigned char* nb = lds + P3_BUF + ((c + 1) & 1) * REC_DMA;
#pragma unroll
            for (int pz = 0; pz < 7; ++pz) { const int piece = wave + 8 * pz; __builtin_amdgcn_global_load_lds((const unsigned*)(rec + piece * 1024 + lane * 16), (LAS unsigned*)(nb + piece * 1024), 16, 0, 0); }
#pragma unroll
            for (int rt = 0; rt < 4; ++rt) Un[rt] = *(const u32x2*)(rec + REC_U + ((rt * 8 + wave) * 64 + lane) * 8);
            gtn = gtarr[(bl * NCHUNK + c + 1) * 8 + h];
            { const int t = 64 * (c + 1) - 48 + zi; const bf16_t* zr = zb + (size_t)(b * LP + t) * D + h * 128 + 16 * zseg; zn0 = *(const u32x4*)zr; zn1 = *(const u32x4*)(zr + 8); }
        }
        if (c > 0) gdn_scan_finalize(lds, c - 1, b, h, tid, zf0, zf1, zb, gnorm_w);
        bf16x8 Sb[4];
#pragma unroll
        for (int s2 = 0; s2 < 4; ++s2) Sb[s2] = pack8(S[2 * s2], S[2 * s2 + 1]);
#define LDF(off) (*(const LAS bf16x8*)(buf + (off) + lane * 16))
#define PIN8(f) asm volatile("" : "+v"(f[0]), "+v"(f[1]), "+v"(f[2]), "+v"(f[3]), "+v"(f[4]), "+v"(f[5]), "+v"(f[6]), "+v"(f[7])); __builtin_amdgcn_sched_barrier(0)
        f32x4 av[4], ao[4];
        bf16x8 fa[8], fb[8];
#pragma unroll
        for (int s2 = 0; s2 < 4; ++s2) { fa[s2] = LDF(REC_WN + (0 * 4 + s2) * 1024); fa[4 + s2] = LDF(REC_QD + (0 * 4 + s2) * 1024); }
#pragma unroll
        for (int rt = 0; rt < 4; ++rt) {
            av[rt] = (f32x4){__uint_as_float(Uc[rt].x << 16), __uint_as_float(Uc[rt].x & 0xffff0000u), __uint_as_float(Uc[rt].y << 16), __uint_as_float(Uc[rt].y & 0xffff0000u)};
            ao[rt] = z4;
            bf16x8 (&cur)[8] = (rt & 1) ? fb : fa; bf16x8 (&nxt)[8] = (rt & 1) ? fa : fb;
            if (rt < 3) {
#pragma unroll
                for (int s2 = 0; s2 < 4; ++s2) { nxt[s2] = LDF(REC_WN + ((rt + 1) * 4 + s2) * 1024); nxt[4 + s2] = LDF(REC_QD + ((rt + 1) * 4 + s2) * 1024); }
            } else {
#pragma unroll
                for (int q = 0; q < 8; ++q) nxt[q] = LDF(REC_AM + q * 1024);
            }
            PIN8(cur);
#pragma unroll
            for (int s2 = 0; s2 < 4; ++s2) { av[rt] = MFMA16(cur[s2], Sb[s2], av[rt]); ao[rt] = MFMA16(cur[4 + s2], Sb[s2], ao[rt]); }
            __builtin_amdgcn_sched_barrier(0);
        }
        bf16x8 Vb[2];
#pragma unroll
        for (int s = 0; s < 2; ++s) Vb[s] = pack8(av[2 * s], av[2 * s + 1]);
#pragma unroll
        for (int q = 0; q < 8; ++q) fb[q] = LDF(REC_KDT + q * 1024);
        PIN8(fa);
#pragma unroll
        for (int rt = 0; rt < 4; ++rt)
#pragma unroll
            for (int s = 0; s < 2; ++s) ao[rt] = MFMA16(fa[rt * 2 + s], Vb[s], ao[rt]);
        __builtin_amdgcn_sched_barrier(0);
#pragma unroll
        for (int q = 0; q < 8; ++q) fa[q] = LDF(REC_KDT + (8 + q) * 1024);
        PIN8(fb);
#pragma unroll
        for (int dt = 0; dt < 4; ++dt) { S[dt] = S[dt] * gt;
#pragma unroll
            for (int s = 0; s < 2; ++s) S[dt] = MFMA16(fb[dt * 2 + s], Vb[s], S[dt]); }
        __builtin_amdgcn_sched_barrier(0);
        PIN8(fa);
#pragma unroll
        for (int dt = 4; dt < 8; ++dt) { S[dt] = S[dt] * gt;
#pragma unroll
            for (int s = 0; s < 2; ++s) S[dt] = MFMA16(fa[(dt - 4) * 2 + s], Vb[s], S[dt]); }
#undef LDF
#undef PIN8
        { LAS unsigned char* ost = lds + P3_OST + (c & 1) * P3_OSTB;
#pragma unroll
          for (int rt = 0; rt < 4; ++rt)
#pragma unroll
            for (int r = 0; r < 4; ++r) { const int i = 16 * rt + 4 * g + r; const float v = ao[rt][r];
                *(LAS bf16_t*)(ost + (i * 132 + 16 * wave + l15) * 2) = (bf16_t)(cvt_pk_bf16(v, 0.f) & 0xffffu); } }
        asm volatile("s_waitcnt vmcnt(0)" ::: "memory");
        __syncthreads();
    }
    gdn_scan_finalize(lds, NCHUNK - 1, b, h, tid, zp0, zp1, zb, gnorm_w);
#pragma unroll
    for (int dt = 0; dt < 8; ++dt)
#pragma unroll
        for (int r = 0; r < 4; ++r) Sout[(size_t)(16 * dt + 4 * g + r) * DV + 16 * wave + l15] = S[dt][r];
    __syncthreads();
}

constexpr int PS_QS = 0, PS_KS = 4096, PS_VS = 8192, PS_OS = 12288, PS_B = 16384, PS_SST = 16512;
__device__ __forceinline__ void gdn_sample_item(LAS unsigned char* lds, int item, const bf16_t* qkv, const float* bg, const float* gconv_w, const float* st_gconv, const float* st_grec, bf16_t* zb, const float* gnorm_w, float* srec) {
    const int tid = fresh_tid(), lane = tid & 63, wave = __builtin_amdgcn_readfirstlane(tid >> 6);
    const int sb = item >> 3, h = item & 7, rowbase = NPROMPT + sb * DECS;
    LAS float* qs = (LAS float*)(lds + PS_QS); LAS float* ks = (LAS float*)(lds + PS_KS); LAS float* vs = (LAS float*)(lds + PS_VS); LAS float* os = (LAS float*)(lds + PS_OS);
    LAS float* bs = (LAS float*)(lds + PS_B); LAS float* eas = bs + 8; LAS float* Sst = (LAS float*)(lds + PS_SST);
    const int cq = tid >> 4, dki = tid & 15;
    const float* S0 = st_grec + ((size_t)sb * NH + h) * DK * DV;
#pragma unroll
    for (int rr = 0; rr < 8; ++rr) { const int dk = (tid >> 5) + 16 * rr, c4 = 4 * (tid & 31); *(LAS f32x4*)(Sst + dk * 132 + c4) = *(const f32x4*)(S0 + (size_t)dk * DV + c4); }
    for (int task = tid; task < 768; task += NTHREADS) { const int ch = task % 384, half = task / 384, part = ch >> 7, colq = part * 1024 + h * 128 + (ch & 127);
        LAS float* dst = (part == 0 ? qs : part == 1 ? ks : vs) + (ch & 127);
        const float w0 = gconv_w[colq], w1 = gconv_w[CONVCH + colq], w2 = gconv_w[2 * CONVCH + colq], w3 = gconv_w[3 * CONVCH + colq];
        const int tb = 4 * half; float xm[3];
#pragma unroll
        for (int j = 0; j < 3; ++j) { const int tt = tb - 3 + j; xm[j] = tt >= 0 ? bf2f(qkv[(size_t)(rowbase + tt) * CONVCH + colq]) : st_gconv[((size_t)sb * 3 + (3 + tt)) * CONVCH + colq]; }
#pragma unroll
        for (int i = 0; i < 4; ++i) { const float xc = bf2f(qkv[(size_t)(rowbase + tb + i) * CONVCH + colq]);
            const float y = w0 * xm[0] + w1 * xm[1] + w2 * xm[2] + w3 * xc; xm[0] = xm[1]; xm[1] = xm[2]; xm[2] = xc; dst[(tb + i) * 128] = silu_f(y); } }
    if (tid < 8) { const float* b2 = bg + (size_t)(rowbase + tid) * 16; bs[tid] = b2[h]; eas[tid] = __expf(b2[8 + h]); }
    __syncthreads();
    if (tid < 256) { const int vec = tid >> 4, part = tid & 15; LAS float* vp = (vec < 8 ? qs + vec * 128 : ks + (vec - 8) * 128) + 8 * part;
        const f32x4 a = *(LAS f32x4*)vp, b = *(LAS f32x4*)(vp + 4);
        float ss = (a.x * a.x + a.y * a.y) + (a.z * a.z + a.w * a.w) + (b.x * b.x + b.y * b.y) + (b.z * b.z + b.w * b.w);
        ss = row16_sum(ss);
        float sc = rsqrtf(ss + EPS); if (vec < 8) sc *= 0.08838834764831845f;
        *(LAS f32x4*)vp = a * sc; *(LAS f32x4*)(vp + 4) = b * sc; }
    float Sr[4][8];
#pragma unroll
    for (int cc = 0; cc < 4; ++cc)
#pragma unroll
        for (int j = 0; j < 8; ++j) Sr[cc][j] = Sst[(8 * dki + j) * 132 + cq + 32 * cc];
    __syncthreads();
#pragma unroll 1
    for (int tt = 0; tt < DECS; ++tt) {
        const float a = eas[tt], be = bs[tt];
        const f32x4 k0 = *(const LAS f32x4*)(ks + tt * 128 + 8 * dki), k1 = *(const LAS f32x4*)(ks + tt * 128 + 8 * dki + 4);
        const f32x4 q0 = *(const LAS f32x4*)(qs + tt * 128 + 8 * dki), q1 = *(const LAS f32x4*)(qs + tt * 128 + 8 * dki + 4);
#pragma unroll
        for (int cc = 0; cc < 4; ++cc) { float part = 0.f;
#pragma unroll
            for (int j = 0; j < 8; ++j) { Sr[cc][j] *= a; part += (j < 4 ? k0[j] : k1[j - 4]) * Sr[cc][j]; }
            part = row16_sum(part);
            const float uu = be * (vs[tt * 128 + cq + 32 * cc] - part); float po = 0.f;
#pragma unroll
            for (int j = 0; j < 8; ++j) { Sr[cc][j] += (j < 4 ? k0[j] : k1[j - 4]) * uu; po += (j < 4 ? q0[j] : q1[j - 4]) * Sr[cc][j]; }
            po = row16_sum(po);
            if (dki == 0) os[tt * 128 + cq + 32 * cc] = po; }
    }
#pragma unroll
    for (int cc = 0; cc < 4; ++cc)
#pragma unroll
        for (int j = 0; j < 8; ++j) Sst[(8 * dki + j) * 132 + cq + 32 * cc] = Sr[cc][j];
    __syncthreads();
    { const int tt = wave; const float o0 = os[tt * 128 + lane], o1 = os[tt * 128 + 64 + lane];
      const float rstd = rsqrtf(wave_sum(o0 * o0 + o1 * o1) * (1.f / DV) + EPS);
      bf16_t* zr = zb + (size_t)(rowbase + tt) * D + h * 128;
      const float z0 = bf2f(zr[lane]), z1 = bf2f(zr[64 + lane]);
      zr[lane] = (bf16_t)(cvt_pk_bf16(o0 * rstd * gnorm_w[lane] * silu_f(z0), 0.f) & 0xffffu); zr[64 + lane] = (bf16_t)(cvt_pk_bf16(o1 * rstd * gnorm_w[64 + lane] * silu_f(z1), 0.f) & 0xffffu); }
    float* So = srec + ((size_t)sb * NH + h) * DK * DV;
#pragma unroll
    for (int rr = 0; rr < 8; ++rr) { const int dk = (tid >> 5) + 16 * rr, c4 = 4 * (tid & 31); *(f32x4*)(So + (size_t)dk * DV + c4) = *(const LAS f32x4*)(Sst + dk * 132 + c4); }
    __syncthreads();
}

#define XB_TMO      128
#define XB_XCNT(j)  (256  + 64 * (j))
#define XB_XSUB(j)  (1280 + 64 * (j))
#define XB_XGEN(j)  (2304 + 64 * (j))
#define XB_TOP      3328
#define XB_TOPGEN   3392
#define XCD_BAR_WORDS 3456
#define XB_SPIN_CAP (1u << 20)
__device__ __forceinline__ unsigned xb_ld(unsigned* p)              { return __hip_atomic_load(p, __ATOMIC_RELAXED, __HIP_MEMORY_SCOPE_AGENT); }
__device__ __forceinline__ unsigned xb_add(unsigned* p, unsigned v) { return __hip_atomic_fetch_add(p, v, __ATOMIC_RELAXED, __HIP_MEMORY_SCOPE_AGENT); }
__device__ __forceinline__ unsigned xb_xcc_id() { return (unsigned)__builtin_amdgcn_s_getreg((3 << 11) | 20) & 0xFu; }
#define XB_SPIN(cond, bar) do { unsigned _sp = 0; while (cond) { __builtin_amdgcn_s_sleep(1); \
    if ((++_sp & 255u) == 0u) { if (xb_ld(&(bar)[XB_TMO])) break; if (_sp > XB_SPIN_CAP) { atomicAdd(&(bar)[XB_TMO], 1u); break; } } } } while (0)
struct XcdBarrier { unsigned* bar; unsigned x; volatile LAS unsigned* st; };
__device__ __forceinline__ XcdBarrier xcd_barrier_post(unsigned* bar, volatile LAS unsigned* st) {
    XcdBarrier b; b.bar = bar; b.x = xb_xcc_id(); b.st = st;
    if (threadIdx.x == 0) (void)xb_add(&bar[XB_XCNT(b.x)], 1u);
    return b;
}
__device__ __forceinline__ void xcd_barrier_complete(unsigned* bar, unsigned x, unsigned& nloc, unsigned& nx) {
    const unsigned G = gridDim.x * gridDim.y * gridDim.z;
    unsigned sum, cnt, mine, sp = 0u;
    for (;;) {
        sum = 0u; cnt = 0u; mine = 0u;
#pragma unroll
        for (unsigned j = 0; j < 16; ++j) { const unsigned c = xb_ld(&bar[XB_XCNT(j)]); sum += c; cnt += (c > 0u) ? 1u : 0u; mine = (j == x) ? c : mine; }
        if (sum == G) break;
        __builtin_amdgcn_s_sleep(1);
        if ((++sp & 255u) == 0u) { if (xb_ld(&bar[XB_TMO])) break; if (sp > XB_SPIN_CAP) { atomicAdd(&bar[XB_TMO], 1u); break; } }
    }
    nloc = mine > 0u ? mine : 1u; nx = cnt > 0u ? cnt : 1u;
}
__device__ __forceinline__ void xcd_barrier(const XcdBarrier& b) {
    asm volatile("s_waitcnt vmcnt(0)" ::: "memory");
    __syncthreads();
    if (threadIdx.x == 0) {
        unsigned* bar = b.bar;
        unsigned bx_ = (unsigned)__builtin_amdgcn_readfirstlane((int)xb_xcc_id()); asm volatile("" : "+s"(bx_));
        __builtin_amdgcn_s_waitcnt(0);
        unsigned nloc = b.st[0], nx = b.st[1];
        if (nloc == 0u) { xcd_barrier_complete(bar, bx_, nloc, nx); b.st[0] = nloc; b.st[1] = nx; }
        const unsigned old = xb_add(&bar[XB_XSUB(bx_)], 1u);
        const unsigned gen = old / nloc;
        if (old + 1u == (gen + 1u) * nloc) {
            __builtin_amdgcn_fence(__ATOMIC_RELEASE, "agent");
            asm volatile("s_waitcnt vmcnt(0)" ::: "memory");
            const unsigned og = xb_add(&bar[XB_TOP], 1u);
            const unsigned tg = og / nx;
            if (og + 1u == (tg + 1u) * nx) xb_add(&bar[XB_TOPGEN], 1u);
            else XB_SPIN(xb_ld(&bar[XB_TOPGEN]) == tg, bar);
            __builtin_amdgcn_fence(__ATOMIC_ACQUIRE, "agent");
            xb_add(&bar[XB_XGEN(bx_)], 1u);
            asm volatile("s_waitcnt vmcnt(0)" ::: "memory");
        } else {
            XB_SPIN(xb_ld(&bar[XB_XGEN(bx_)]) == gen, bar);
            __builtin_amdgcn_fence(__ATOMIC_ACQUIRE, "agent");
            asm volatile("s_waitcnt vmcnt(0)" ::: "memory");
        }
    }
    __syncthreads();
}

__device__ __forceinline__ void transpose_item(const float* W, int ldn, int K, bf16_t* WT, int dst_row0, const float* rowscale, LAS float* scr, int kb, int n0, int lane, const float* kscale = nullptr) {
    const int k0 = 64 * kb;
#pragma unroll 8
    for (int i = 0; i < 32; ++i) { const int kk = 2 * i + (lane >> 5); scr[kk * 33 + (lane & 31)] = W[(size_t)(k0 + kk) * ldn + n0 + (lane & 31)]; }
    asm volatile("s_waitcnt lgkmcnt(0)" ::: "memory");
    const int c = lane & 7;
    float ks[8];
#pragma unroll
    for (int e = 0; e < 8; ++e) ks[e] = kscale ? kscale[k0 + 8 * c + e] : 1.0f;
#pragma unroll
    for (int j = 0; j < 4; ++j) { const int n = (lane >> 3) + 8 * j; const LAS float* s = scr + (8 * c) * 33 + n; const float sc = rowscale ? rowscale[dst_row0 + n] : 1.0f;
        u32x4 o; o.x = cvt_pk_bf16(s[0 * 33] * sc * ks[0], s[1 * 33] * sc * ks[1]); o.y = cvt_pk_bf16(s[2 * 33] * sc * ks[2], s[3 * 33] * sc * ks[3]); o.z = cvt_pk_bf16(s[4 * 33] * sc * ks[4], s[5 * 33] * sc * ks[5]); o.w = cvt_pk_bf16(s[6 * 33] * sc * ks[6], s[7 * 33] * sc * ks[7]);
        *(u32x4*)(WT + (size_t)(dst_row0 + n) * K + k0 + 8 * c) = o; }
    asm volatile("s_waitcnt lgkmcnt(0)" ::: "memory");
}


__device__ __forceinline__ unsigned char* gdn_rec(unsigned char* ws, float* out, int slot) {
    return slot < N_REC_WS ? ws + WS_R1 + (size_t)slot * REC_BYTES : (unsigned char*)out + (size_t)(slot - N_REC_WS) * REC_BYTES;
}
__device__ __forceinline__ void gdn_all(LAS unsigned char* lds, const XcdBarrier& xbar, const int G, const int bx, unsigned char* ws, float* out, const bf16_t* qkv, const float* bg, const float* gconv_w,
                                        float* gtarr, bf16_t* zb, const float* gnorm_w, const float* st_gconv, const float* st_grec) {
    {
        { PrepRaw R; if (bx < NITEM_P) gdn_prep_load(R, bx, 0, qkv, bg, fresh_tid());
          for (int item = bx; item < NITEM_P; item += G) gdn_prep_item(lds, item, 0, R, item + G < NITEM_P ? item + G : -1, qkv, bg, gconv_w, gdn_rec(ws, out, item), gtarr); }
        {
            const int tid = fresh_tid();
            const int gt = bx * NTHREADS + tid, NGT = G * NTHREADS;
            for (int i = gt; i < (BATCH + DECB) * 3 * CONVCH; i += NGT) { const int c = i % CONVCH, j = (i / CONVCH) % 3, seq = i / (3 * CONVCH);
                if (seq < BATCH) out[O_PCONV + ((size_t)seq * 3 + j) * CONVCH + c] = bf2f(qkv[(size_t)(seq * LP + LP - 3 + j) * CONVCH + c]);
                else { const int sb = seq - BATCH; out[O_SCONV + ((size_t)sb * 3 + j) * CONVCH + c] = bf2f(qkv[(size_t)(NPROMPT + sb * DECS + DECS - 3 + j) * CONVCH + c]); } }
        }
    }
    xcd_barrier(xbar);
    {
        auto rec_of = [=](int slot) -> const unsigned char* { return gdn_rec(ws, out, slot); };
        if (bx < 64) gdn_scan(lds, bx, 0, rec_of, gtarr, zb, gnorm_w, out + O_PREC + (size_t)bx * DK * DV);
        else for (int it = bx - 64; it < DECB * NH; it += G - 64) gdn_sample_item(lds, it, qkv, bg, gconv_w, st_gconv, st_grec, zb, gnorm_w, out + O_SREC);
    }
    xcd_barrier(xbar);
}

struct Params {
    const float* in[22];
    float* out; unsigned char* ws;
};

__device__ __forceinline__ void rownorm_to_bf16(const float* xrow, const float* w, bf16_t* orow, int lane) {
    const f32x4* xr = (const f32x4*)xrow + lane; const f32x4* wr4 = (const f32x4*)w + lane;
    f32x4 v[4]; float s = 0.f;
#pragma unroll
    for (int j = 0; j < 4; ++j) { v[j] = xr[64 * j]; s += (v[j].x * v[j].x + v[j].y * v[j].y) + (v[j].z * v[j].z + v[j].w * v[j].w); }
    const float rstd = rsqrtf(wave_sum(s) * (1.f / D) + EPS);
    unsigned long long* o8 = (unsigned long long*)orow + lane;
#pragma unroll
    for (int j = 0; j < 4; ++j) { const f32x4 ww = wr4[64 * j]; const f32x4 h = v[j] * rstd * ww;
        o8[64 * j] = (unsigned long long)cvt_pk_bf16(h.x, h.y) | ((unsigned long long)cvt_pk_bf16(h.z, h.w) << 32); }
}

template <int WIN, int RUN> __device__ __forceinline__ void pool_run(const bf16_t* xb, const float* rss1, const float* nmw, bf16_t* pb, int r0, int t0, int c) {
    constexpr int NB = WIN - 1, NR = NB + RUN;
    u32x4 raw[NR]; float rsv[NR];
#pragma unroll
    for (int q = 0; q < NR; ++q) { raw[q] = (u32x4){0u, 0u, 0u, 0u}; rsv[q] = 0.f;
        if (q >= NB || t0 + q - NB >= 0) { raw[q] = *(const u32x4*)(xb + (size_t)(r0 + q - NB) * D + c); rsv[q] = rss1[r0 + q - NB]; } }
    float w8[8]; { const f32x4 a = *(const f32x4*)(nmw + c), b = *(const f32x4*)(nmw + c + 4); w8[0] = a[0]; w8[1] = a[1]; w8[2] = a[2]; w8[3] = a[3]; w8[4] = b[0]; w8[5] = b[1]; w8[6] = b[2]; w8[7] = b[3]; }
#define POOL_H(dst, q_) do { const float _rs = rsqrtf(rsv[q_] * (1.f / D) + EPS); const unsigned _vv[4] = {raw[q_].x, raw[q_].y, raw[q_].z, raw[q_].w}; \
        _Pragma("unroll") for (int _e = 0; _e < 4; ++_e) { dst[2 * _e] = __uint_as_float(_vv[_e] << 16) * _rs * w8[2 * _e]; dst[2 * _e + 1] = __uint_as_float(_vv[_e] & 0xffff0000u) * _rs * w8[2 * _e + 1]; } } while (0)
    float acc8[8];
#pragma unroll
    for (int e = 0; e < 8; ++e) acc8[e] = 0.f;
#pragma unroll
    for (int q = NB - 1; q >= 0; --q) { float h8[8]; POOL_H(h8, q);
#pragma unroll
        for (int e = 0; e < 8; ++e) acc8[e] += h8[e]; }
#pragma unroll
    for (int k = 0; k < RUN; ++k) { const int t = t0 + k;
        float h8[8]; POOL_H(h8, NB + k);
#pragma unroll
        for (int e = 0; e < 8; ++e) acc8[e] += h8[e];
        const int cnt = WIN < t + 1 ? WIN : t + 1; const float inv = 1.0f / (float)cnt;
        u32x4 w; w.x = cvt_pk_bf16(acc8[0] * inv - h8[0], acc8[1] * inv - h8[1]); w.y = cvt_pk_bf16(acc8[2] * inv - h8[2], acc8[3] * inv - h8[3]);
        w.z = cvt_pk_bf16(acc8[4] * inv - h8[4], acc8[5] * inv - h8[5]); w.w = cvt_pk_bf16(acc8[6] * inv - h8[6], acc8[7] * inv - h8[7]);
        *(u32x4*)(pb + (size_t)(r0 + k) * D + c) = w;
        { float o8[8]; POOL_H(o8, k);
#pragma unroll
          for (int e = 0; e < 8; ++e) acc8[e] -= o8[e]; }
    }
#undef POOL_H
}

template <int WIN> __device__ __forceinline__ void pool_sample(const bf16_t* xb, const float* rss1, const float* nmw, const float* st_pool, bf16_t* pb, int r, int c) {
    const int sq = (r - NPROMPT) >> 3, t = (r - NPROMPT) & 7;
    float w8[8]; { const f32x4 a = *(const f32x4*)(nmw + c), b = *(const f32x4*)(nmw + c + 4); w8[0] = a[0]; w8[1] = a[1]; w8[2] = a[2]; w8[3] = a[3]; w8[4] = b[0]; w8[5] = b[1]; w8[6] = b[2]; w8[7] = b[3]; }
    float acc8[8], h8[8];
#pragma unroll
    for (int e = 0; e < 8; ++e) { acc8[e] = 0.f; h8[e] = 0.f; }
#pragma unroll
    for (int j = 0; j < WIN; ++j) {
        const int tt = t - j;
        if (j < 8 && tt >= 0) { const u32x4 v = *(const u32x4*)(xb + (size_t)(r - j) * D + c); const float rs = rsqrtf(rss1[r - j] * (1.f / D) + EPS); const unsigned vv[4] = {v.x, v.y, v.z, v.w};
#pragma unroll
            for (int e = 0; e < 4; ++e) { const float a = __uint_as_float(vv[e] << 16) * rs * w8[2 * e], b = __uint_as_float(vv[e] & 0xffff0000u) * rs * w8[2 * e + 1];
                acc8[2 * e] += a; acc8[2 * e + 1] += b; if (j == 0) { h8[2 * e] = a; h8[2 * e + 1] = b; } } }
        else { const float* sp = st_pool + ((size_t)sq * 15 + (15 + tt)) * D + c; const f32x4 a = *(const f32x4*)sp, b = *(const f32x4*)(sp + 4);
#pragma unroll
            for (int e = 0; e < 4; ++e) { acc8[e] += a[e]; acc8[4 + e] += b[e]; } }
    }
    const float inv = 1.0f / (float)WIN;
    u32x4 w; w.x = cvt_pk_bf16(acc8[0] * inv - h8[0], acc8[1] * inv - h8[1]); w.y = cvt_pk_bf16(acc8[2] * inv - h8[2], acc8[3] * inv - h8[3]);
    w.z = cvt_pk_bf16(acc8[4] * inv - h8[4], acc8[5] * inv - h8[5]); w.w = cvt_pk_bf16(acc8[6] * inv - h8[6], acc8[7] * inv - h8[7]);
    *(u32x4*)(pb + (size_t)r * D + c) = w;
}

__global__ void __launch_bounds__(NTHREADS, 2) fwd_megakernel(Params p) {
    extern __shared__ __attribute__((aligned(16))) unsigned char lds_raw[];
    LAS unsigned char* lds = (LAS unsigned char*)lds_raw;
    cg::grid_group grid = cg::this_grid();
    if (threadIdx.x < 2) ((volatile LAS unsigned*)(lds + LDS_MISC))[threadIdx.x] = 0u;
    __syncthreads();
    const XcdBarrier xbar = xcd_barrier_post((unsigned*)(p.ws + WS_CTL) + 1024, (volatile LAS unsigned*)(lds + LDS_MISC));
#define GRID_SYNC() xcd_barrier(xbar)
    const int G = gridDim.x, bx = blockIdx.x, NGW = G * NWAVES;
#define PHASE_IDS() const int tid = fresh_tid(), lane = tid & 63, wave = __builtin_amdgcn_readfirstlane(tid >> 6), gw = bx * NWAVES + wave; (void)lane; (void)gw
    unsigned char* ws = p.ws;
    const float* x_prompt = p.in[0]; const float* x_sample = p.in[1]; const float* st_gconv = p.in[2]; const float* st_grec = p.in[3]; const float* st_pool = p.in[4]; const float* st_ffn = p.in[5];
    const float* meta = p.in[6]; const float* norm_mix = p.in[7]; const float* norm_ffn = p.in[8]; const float* w_in = p.in[9]; const float* gconv_w = p.in[10]; const float* A_log = p.in[11];
    const float* dt_bias = p.in[12]; const float* gnorm_w = p.in[13]; const float* w_out = p.in[14]; const float* pool_w = p.in[15]; const float* pool_scale = p.in[16]; const float* w_up = p.in[17];
    const float* fconv_w = p.in[18]; const float* fconv_b = p.in[19]; const float* w_down = p.in[20]; const float* norm_final = p.in[21];
    float* out = p.out;
    bf16_t* Win_t = (bf16_t*)(ws + WS_WIN); bf16_t* Wout_t = (bf16_t*)(ws + WS_WOUT); float* bg = (float*)(ws + WS_BG); bf16_t* hb0 = (bf16_t*)(ws + WS_HB0); bf16_t* xb = (bf16_t*)(ws + WS_XB); float* rss = (float*)(ws + WS_RSS);
    bf16_t* qkv = (bf16_t*)(ws + WS_QKV); bf16_t* zb = (bf16_t*)(ws + WS_Z); float* gtarr = (float*)(ws + WS_GT);
    bf16_t* actb = (bf16_t*)(ws + WS_ACT); bf16_t* Wup_t = (bf16_t*)(ws + WS_WUP); bf16_t* Wdn_t = (bf16_t*)(ws + WS_WDN); bf16_t* Wp_t = (bf16_t*)(ws + WS_WP);
    bf16_t* pb = actb;

    {
        PHASE_IDS();
        for (int i = bx * NTHREADS + tid; i < 3 * TP; i += G * NTHREADS) rss[i] = 0.f;
        LAS float* scr = (LAS float*)(lds + wave * 16384);
        constexpr int I_IN = 16 * 128, I_OUT = 16 * 32, I_X = 16;
        for (int it = gw; it < I_IN + I_OUT + I_X; it += NGW) {
            if (it < I_IN) { const int kb = it / 128, nb = it % 128; transpose_item(w_in, GPROJ, D, Win_t, 32 * nb, nullptr, scr, kb, 32 * nb, lane); }
            else if (it < I_IN + I_OUT) { const int r = it - I_IN, kb = r / 32, nb = r % 32; transpose_item(w_out, D, D, Wout_t, 32 * nb, nullptr, scr, kb, 32 * nb, lane); }
            else { const int kb = it - I_IN - I_OUT, k0 = 64 * kb;
#pragma unroll 8
                for (int i = 0; i < 32; ++i) { const int kk = 2 * i + (lane >> 5), n = lane & 31; scr[kk * 33 + n] = n < 16 ? w_in[(size_t)(k0 + kk) * GPROJ + 4096 + n] : 0.f; }
                asm volatile("s_waitcnt lgkmcnt(0)" ::: "memory");
                const int c = lane & 7;
#pragma unroll
                for (int j = 0; j < 4; ++j) { const int n = (lane >> 3) + 8 * j; const LAS float* sp = scr + (8 * c) * 33 + n;
                    u32x4 o; o.x = cvt_pk_bf16(sp[0 * 33], sp[1 * 33]); o.y = cvt_pk_bf16(sp[2 * 33], sp[3 * 33]); o.z = cvt_pk_bf16(sp[4 * 33], sp[5 * 33]); o.w = cvt_pk_bf16(sp[6 * 33], sp[7 * 33]);
                    *(u32x4*)(Win_t + (size_t)(4096 + n) * D + k0 + 8 * c) = o; }
                asm volatile("s_waitcnt lgkmcnt(0)" ::: "memory"); }
        }
        const f32x4* nw4 = (const f32x4*)norm_mix + lane;
        f32x4 nv[4], nv2[4];
        { const float* xrow = x0_row(x_prompt, x_sample, meta, gw);
#pragma unroll
            for (int j = 0; j < 4; ++j) nv[j] = xrow ? ((const f32x4*)xrow + lane)[64 * j] : (f32x4){0.f, 0.f, 0.f, 0.f}; }
        { const float* xrow = gw + NGW < TP ? x0_row(x_prompt, x_sample, meta, gw + NGW) : nullptr;
#pragma unroll
            for (int j = 0; j < 4; ++j) nv2[j] = xrow ? ((const f32x4*)xrow + lane)[64 * j] : (f32x4){0.f, 0.f, 0.f, 0.f}; }
        for (int r = gw; r < TP; r += NGW) {
            f32x4 v[4];
#pragma unroll
            for (int j = 0; j < 4; ++j) { v[j] = nv[j]; nv[j] = nv2[j]; }
            if (r + 2 * NGW < TP) { const float* xrow = x0_row(x_prompt, x_sample, meta, r + 2 * NGW);
#pragma unroll
                for (int j = 0; j < 4; ++j) nv2[j] = xrow ? ((const f32x4*)xrow + lane)[64 * j] : (f32x4){0.f, 0.f, 0.f, 0.f}; }
            float ssq = 0.f;
#pragma unroll
            for (int j = 0; j < 4; ++j) ssq += (v[j].x * v[j].x + v[j].y * v[j].y) + (v[j].z * v[j].z + v[j].w * v[j].w);
            const float rstd = rsqrtf(wave_sum(ssq) * (1.f / D) + EPS);
            unsigned long long* o8 = (unsigned long long*)(hb0 + (size_t)r * D) + lane;
#pragma unroll
            for (int j = 0; j < 4; ++j) { const f32x4 h = v[j] * rstd * nw4[64 * j];
                o8[64 * j] = (unsigned long long)cvt_pk_bf16(h.x, h.y) | ((unsigned long long)cvt_pk_bf16(h.z, h.w) << 32); }
        }
    }
    GRID_SYNC();

    {
        pg8::Gemm g{hb0, Win_t, D, D, 0}; pg8::StaticOrder S; S.init(69, 17, G, bx, false);
        pg8::EpiQKVZ E{qkv, zb, bg, A_log, dt_bias};
        for (int rep = 0; rep < REP_G1; ++rep) pg8::gemm_phase<pg8::EpiQKVZ, true, true>(lds, g, S, E);
    }
    GRID_SYNC();

    gdn_all(lds, xbar, G, bx, ws, out, qkv, bg, gconv_w, gtarr, zb, gnorm_w, st_gconv, st_grec);

    {
        PHASE_IDS();
        LAS float* scr = (LAS float*)(lds + wave * 16384);
        constexpr int I_UP = 16 * 176, I_DN = 44 * 32, I_P = 4 * 8;
        constexpr int NIT = 2 * I_UP + 2 * I_DN + 4 * I_P;
        for (int it = gw; it < NIT; it += NGW) {
            int r = it;
            if (r < 2 * I_UP) { const int l = r / I_UP; r -= l * I_UP; const int kb = r / 176, nb = r % 176, n0 = 32 * nb;
                const int bj = n0 / DFF, rem = n0 - bj * DFF, pnn = rem >> 7, c0 = rem & 127;
                transpose_item(w_up + (size_t)l * D * DFF2, DFF2, D, Wup_t + (size_t)l * DFF2 * D, pnn * 256 + bj * 128 + c0, nullptr, scr, kb, n0, lane, norm_ffn + l * D); continue; }
            r -= 2 * I_UP;
            if (r < 2 * I_DN) { const int l = r / I_DN; r -= l * I_DN; const int kb = r / 32, nb = r % 32;
                transpose_item(w_down + (size_t)l * DFF * D, D, DFF, Wdn_t + (size_t)l * D * DFF, 32 * nb, nullptr, scr, kb, 32 * nb, lane); continue; }
            r -= 2 * I_DN;
            { const int gi = r / I_P; r -= gi * I_P; const int kb = r / 8, nb = r % 8;
              transpose_item(pool_w + (size_t)gi * 256 * 256, 256, 256, Wp_t + (size_t)gi * 256 * 256, 32 * nb, pool_scale + gi * 256, scr, kb, 32 * nb, lane); }
        }
        __syncthreads();
    }
    {
        pg8::Gemm g{zb, Wout_t, D, D, 0}; pg8::TailOrder S; S.init(69, 4, G, bx, false);
        pg8::EpiRes<true> E{x_prompt, x_sample, meta, xb, rss};
        pg8::gemm_phase<pg8::EpiRes<true>, true, true, pg8::TailOrder>(lds, g, S, E);
    }
    GRID_SYNC();

    for (int layer = 0; layer < 2; ++layer) {
        {
            pg8::Gemm g{xb, Wup_t + (size_t)layer * DFF2 * D, D, D, 0}; pg8::StaticOrder S; S.init(69, 22, G, bx, true);
            pg8::EpiFFNUp<false> E{actb, fconv_w + (size_t)layer * 3 * DFF2, fconv_b + (size_t)layer * DFF2, st_ffn + (size_t)layer * DECB * 2 * DFF2,
                            out + O_PFFN + (size_t)layer * BATCH * 2 * DFF2, out + O_SFFN + (size_t)layer * DECB * 2 * DFF2, (LAS float*)(lds + LDS_BND), rss + (layer == 0 ? 0 : 2 * TP)};
            pg8::gemm_phase<pg8::EpiFFNUp<false>, true, true>(lds, g, S, E);
            pg8::StaticOrder S2; S2.init(69, 22, G, bx, true, true);
            pg8::EpiFFNUp<true> E2{E.act, E.cw, E.cb, E.st, E.outp, E.outs, E.bnd, E.rss};
            pg8::gemm_phase<pg8::EpiFFNUp<true>, true, true>(lds, g, S2, E2);
        }
        GRID_SYNC();
        {
            pg8::Gemm g{actb, Wdn_t + (size_t)layer * D * DFF, DFF, DFF, 0}; pg8::TailOrder S; S.init(69, 4, G, bx, false);
            pg8::EpiRes<false> E{nullptr, nullptr, nullptr, xb, layer == 0 ? rss + TP : nullptr};
            pg8::gemm_phase<pg8::EpiRes<false>, true, true, pg8::TailOrder>(lds, g, S, E);
        }
        GRID_SYNC();
        if (layer == 0) {
            {
                PHASE_IDS();
                const int gt = bx * NTHREADS + tid, NGT = G * NTHREADS;
                const float* rss1 = rss + TP; const float* nmw = norm_mix + D;
                for (int wi = gw; wi < (NPROMPT / 32) * 4; wi += NGW) {
                    const int cg = wi & 3, rr = (wi >> 2) * 2 + (lane >> 5), c = cg * 256 + (lane & 31) * 8;
                    const int sq = rr / (LP / 16), t0 = (rr - sq * (LP / 16)) * 16, r0 = sq * LP + t0;
                    if (cg == 0) pool_run<2, 16>(xb, rss1, nmw, pb, r0, t0, c); else if (cg == 1) pool_run<4, 16>(xb, rss1, nmw, pb, r0, t0, c);
                    else if (cg == 2) pool_run<8, 16>(xb, rss1, nmw, pb, r0, t0, c);
                    else { pool_run<16, 8>(xb, rss1, nmw, pb, r0, t0, c); pool_run<16, 8>(xb, rss1, nmw, pb, r0 + 8, t0 + 8, c); }
                }
                for (int wi = gw; wi < (NSAMP / 2) * 4; wi += NGW) {
                    const int cg = wi & 3, r = NPROMPT + (wi >> 2) * 2 + (lane >> 5), c = cg * 256 + (lane & 31) * 8;
                    if (cg == 0) pool_sample<2>(xb, rss1, nmw, st_pool, pb, r, c); else if (cg == 1) pool_sample<4>(xb, rss1, nmw, st_pool, pb, r, c);
                    else if (cg == 2) pool_sample<8>(xb, rss1, nmw, st_pool, pb, r, c); else pool_sample<16>(xb, rss1, nmw, st_pool, pb, r, c);
                }
                for (int i = gt; i < (BATCH + DECB) * 15 * (D / 8); i += NGT) { const int c = (i & 127) * 8, j = (i >> 7) % 15, seq = (i >> 7) / 15;
                    int r = -1;
                    if (seq < BATCH) r = seq * LP + LP - 15 + j; else if (j >= 7) r = NPROMPT + (seq - BATCH) * DECS + (j - 7);
                    f32x4 o0, o1;
                    if (r >= 0) { const u32x4 v = *(const u32x4*)(xb + (size_t)r * D + c); const float rs = rsqrtf(rss1[r] * (1.f / D) + EPS); const f32x4 wa = *(const f32x4*)(nmw + c), wb = *(const f32x4*)(nmw + c + 4);
                        o0 = (f32x4){__uint_as_float(v.x << 16), __uint_as_float(v.x & 0xffff0000u), __uint_as_float(v.y << 16), __uint_as_float(v.y & 0xffff0000u)} * rs * wa;
                        o1 = (f32x4){__uint_as_float(v.z << 16), __uint_as_float(v.z & 0xffff0000u), __uint_as_float(v.w << 16), __uint_as_float(v.w & 0xffff0000u)} * rs * wb; }
                    else { const float* sp = st_pool + ((size_t)(seq - BATCH) * 15 + 8 + j) * D + c; o0 = *(const f32x4*)sp; o1 = *(const f32x4*)(sp + 4); }
                    float* op = (seq < BATCH) ? out + O_PPOOL + ((size_t)seq * 15 + j) * D + c : out + O_SPOOL + ((size_t)(seq - BATCH) * 15 + j) * D + c;
                    *(f32x4*)op = o0; *(f32x4*)(op + 4) = o1; }
            }
            GRID_SYNC();
            {
                pg8::Gemm g{pb, Wp_t, D, 256, 256}; pg8::TailOrder S; S.init(69, 4, G, bx, false);
                pg8::EpiRes<false> E{nullptr, nullptr, nullptr, xb, rss + 2 * TP};
                pg8::gemm_phase<pg8::EpiRes<false>, true, true, pg8::TailOrder>(lds, g, S, E);
            }
            GRID_SYNC();
        }
    }

    { PHASE_IDS();
    auto ld_row = [&](int r, u32x4 (&w)[2]) { if (r < T) { const u32x4* xr = (const u32x4*)(xb + (size_t)r * D) + lane; w[0] = xr[0]; w[1] = xr[64]; } };
    u32x4 nw[2] = {(u32x4){0u, 0u, 0u, 0u}, (u32x4){0u, 0u, 0u, 0u}}; ld_row(gw, nw);
    for (int r = gw; r < T; r += NGW) {
        u32x4 cw2[2] = {nw[0], nw[1]};
        ld_row(r + NGW, nw);
        float* dst;
        if (r < NPROMPT) { const int b = r / LP, t = r - b * LP; if (t < NMETA) continue; dst = out + O_YP + ((size_t)b * SEQ + (t - NMETA)) * D; }
        else dst = out + O_YS + (size_t)(r - NPROMPT) * D;
        float f[2][8]; float s = 0.f;
#pragma unroll
        for (int j = 0; j < 2; ++j) { const unsigned ww[4] = {cw2[j].x, cw2[j].y, cw2[j].z, cw2[j].w};
#pragma unroll
            for (int e = 0; e < 4; ++e) { f[j][2 * e] = __uint_as_float(ww[e] << 16); f[j][2 * e + 1] = __uint_as_float(ww[e] & 0xffff0000u); s += f[j][2 * e] * f[j][2 * e] + f[j][2 * e + 1] * f[j][2 * e + 1]; } }
        const float rstd = rsqrtf(wave_sum(s) * (1.f / D) + EPS);
#pragma unroll
        for (int j = 0; j < 2; ++j) { const int c = 8 * lane + 512 * j; const f32x4 wa = *(const f32x4*)(norm_final + c), wb = *(const f32x4*)(norm_final + c + 4);
            *(f32x4*)(dst + c) = (f32x4){f[j][0], f[j][1], f[j][2], f[j][3]} * rstd * wa; *(f32x4*)(dst + c + 4) = (f32x4){f[j][4], f[j][5], f[j][6], f[j][7]} * rstd * wb; }
    }
    }
}

extern "C" void kernel_launch(void* const* d_in, const int* in_sizes, int n_in, void* d_out, int out_size, void* d_ws, size_t ws_size, hipStream_t stream) {
    static int grid_blocks = 0;
    if (grid_blocks == 0) {
        if (n_in != 22 || (size_t)out_size != O_END || ws_size < WS_END) { fprintf(stderr, "kernel_launch: unexpected shapes (n_in %d out %d ws %zu)\n", n_in, out_size, ws_size); grid_blocks = -1; return; }
        int dev = 0, cus = 0, per_cu = 0;
        hipGetDevice(&dev);
        hipDeviceGetAttribute(&cus, hipDeviceAttributeMultiprocessorCount, dev);
        if (hipFuncSetAttribute((const void*)fwd_megakernel, hipFuncAttributeMaxDynamicSharedMemorySize, LDS_BYTES) != hipSuccess) { fprintf(stderr, "kernel_launch: hipFuncSetAttribute failed\n"); grid_blocks = -1; return; }
        if (hipOccupancyMaxActiveBlocksPerMultiprocessor(&per_cu, (const void*)fwd_megakernel, NTHREADS, LDS_BYTES) != hipSuccess || per_cu < 1) { fprintf(stderr, "kernel_launch: occupancy query failed (%d)\n", per_cu); per_cu = 1; }
        (void)hipGetLastError();
        grid_blocks = cus * 1;
        if (grid_blocks < 128) { fprintf(stderr, "kernel_launch: needs at least 128 CUs\n"); grid_blocks = -1; return; }
        if (per_cu < 1) grid_blocks = -1;
    }
    if (grid_blocks < 0) return;
    if (hipMemsetAsync((char*)d_ws + WS_CTL, 0, 65536, stream) != hipSuccess) { fprintf(stderr, "kernel_launch: memset failed\n"); return; }
    Params p{};
    for (int i = 0; i < 22; ++i) p.in[i] = (const float*)d_in[i];
    p.out = (float*)d_out; p.ws = (unsigned char*)d_ws;
    void* args[] = {&p};
    hipError_t e = hipLaunchCooperativeKernel((const void*)fwd_megakernel, dim3(grid_blocks), dim3(NTHREADS), args, LDS_BYTES, stream);
    if (e != hipSuccess) fprintf(stderr, "cooperative launch failed: %s (grid %d)\n", hipGetErrorString(e), grid_blocks);
}
```

```cpp
#include <hip/hip_runtime.h>
#include <hip/hip_cooperative_groups.h>
#include <cstdio>
#include <cstdint>
namespace cg = cooperative_groups;

#define LAS __attribute__((address_space(3)))
typedef unsigned short bf16_t;
typedef short bf16x8 __attribute__((ext_vector_type(8)));
typedef float f32x4 __attribute__((ext_vector_type(4)));
typedef float f32x2 __attribute__((ext_vector_type(2)));
typedef unsigned u32x4 __attribute__((ext_vector_type(4)));
typedef unsigned u32x2 __attribute__((ext_vector_type(2)));

constexpr int D = 1024, BATCH = 8, SEQ = 2048, NMETA = 16, LP = SEQ + NMETA  , NPROMPT = BATCH * LP  ;
constexpr int DECB = 128, DECS = 8, NSAMP = DECB * DECS  , T = NPROMPT + NSAMP  , TP = 17664  ;
constexpr int NH = 8, DK = 128, DV = 128, CONVCH = 3072, GPROJ = 4112, DFF = 2816, DFF2 = 5632;
constexpr float EPS = 1e-6f;
constexpr int NWAVES = 8, NTHREADS = 512;
#ifndef REP_G1
#define REP_G1 1
#endif
#ifndef REP_P3
#define REP_P3 1
#endif
#ifndef REP_UP
#define REP_UP 1
#endif
#ifndef REP_RN
#define REP_RN 1
#endif

constexpr size_t O_YP = 0, O_YS = O_YP + (size_t)BATCH * SEQ * D, O_PCONV = O_YS + (size_t)NSAMP * D, O_PREC = O_PCONV + (size_t)BATCH * 3 * CONVCH,
                 O_PPOOL = O_PREC + (size_t)BATCH * NH * DK * DV, O_PFFN = O_PPOOL + (size_t)BATCH * 15 * D, O_SCONV = O_PFFN + (size_t)2 * BATCH * 2 * DFF2,
                 O_SREC = O_SCONV + (size_t)DECB * 3 * CONVCH, O_SPOOL = O_SREC + (size_t)DECB * NH * DK * DV, O_SFFN = O_SPOOL + (size_t)DECB * 15 * D,
                 O_END = O_SFFN + (size_t)2 * DECB * 2 * DFF2;

constexpr size_t MiB = 1u << 20;
constexpr size_t WS_CTL = 0, WS_GT = 128 * 1024, WS_RSS = 256 * 1024  , WS_WOUT = 1 * MiB, WS_BG = 3 * MiB, WS_QKV = 5 * MiB, WS_Z = 109 * MiB, WS_R1 = 144 * MiB, WS_HB0 = 144 * MiB, WS_WIN = 179 * MiB;
constexpr size_t WS_KSP = 5 * MiB  , WS_X = 5 * MiB, WS_XB = 74 * MiB  , WS_ACT = 109 * MiB, WS_WUP = 220 * MiB, WS_WDN = 242 * MiB, WS_WP = 253 * MiB, WS_END = 256 * MiB;
constexpr int N_REC_WS = (int)((WS_END - WS_R1) / 73728);
static_assert(WS_QKV + (size_t)TP * CONVCH * 2 <= WS_Z && WS_Z + (size_t)TP * D * 2 <= WS_R1 && WS_HB0 + (size_t)TP * D * 2 <= WS_WIN && WS_WIN + (size_t)4352 * D * 2 <= WS_END, "ws map 1");
static_assert(WS_RSS + (size_t)3 * TP * 4 <= WS_WOUT && WS_X + (size_t)TP * D * 4 <= WS_XB && WS_XB + (size_t)TP * D * 2 <= WS_ACT && WS_ACT + (size_t)TP * DFF * 2 <= WS_WUP && WS_WUP + (size_t)2 * DFF2 * D * 2 <= WS_WDN && WS_WDN + (size_t)2 * D * DFF * 2 <= WS_WP && WS_WP + (size_t)D * 256 * 2 <= WS_END, "ws map 2");
static_assert((size_t)(2112 - N_REC_WS) * 73728 <= (size_t)BATCH * SEQ * D * 4, "GDN records spill into y_prompt");
constexpr int LDS_BYTES = 163840;
constexpr int LDS_MISC = 163776;
constexpr int LDS_BND = 131072;

__device__ __forceinline__ float bf2f(bf16_t b) { return __uint_as_float(((unsigned)b) << 16); }
typedef __bf16 bf16x2_t __attribute__((ext_vector_type(2)));
__device__ __forceinline__ unsigned cvt_pk_bf16(float lo, float hi) { const bf16x2_t r = __builtin_convertvector((f32x2){lo, hi}, bf16x2_t); return __builtin_bit_cast(unsigned, r); }
__device__ __forceinline__ float silu_f(float x) { return x * __builtin_amdgcn_rcpf(1.0f + __expf(-x)); }
__device__ __forceinline__ float wave_sum(float v) {
#pragma unroll
    for (int o = 1; o < 64; o <<= 1) v += __shfl_xor(v, o);
    return v;
}
__device__ __forceinline__ const float* x0_row(const float* xp, const float* xs, const float* meta, int r) {
    if (r < NPROMPT) { const int b = r / LP, t = r - b * LP; return t < NMETA ? meta + (size_t)t * D : xp + ((size_t)b * SEQ + (t - NMETA)) * D; }
    if (r < T) return xs + (size_t)(r - NPROMPT) * D;
    return nullptr;
}
__device__ __forceinline__ int fresh_tid() { int t = threadIdx.x; asm volatile("" : "+v"(t)); return t; }
template <int CTRL> __device__ __forceinline__ float dpp_r(float src) {
    return __builtin_bit_cast(float, __builtin_amdgcn_update_dpp(__builtin_bit_cast(int, src), __builtin_bit_cast(int, src), CTRL, 0xf, 0xf, false));
}
template <int CTRL> __device__ __forceinline__ float dpp_f(float old, float src) {
    return __builtin_bit_cast(float, __builtin_amdgcn_update_dpp(__builtin_bit_cast(int, old), __builtin_bit_cast(int, src), CTRL, 0xf, 0xf, false));
}

namespace pg8 {
constexpr int BM = 256, BK = 64, HALF = 128, HTB = HALF * BK * 2, STAGE_BYTES = 8 * HTB, NXCD = 8, WGM = 4;
__host__ __device__ __forceinline__ int lds_byte(int r, int c) { const int st = (r >> 4) * 2 + (c >> 5), rr = r & 15, cc = c & 31, ob = rr * 64 + cc * 2; return st * 1024 + (ob ^ (((ob >> 9) & 1) << 5)); }
__host__ __device__ __forceinline__ void stage_rc(int b, int& R, int& C) { const int st = b / 1024, sb = b % 1024, swz = sb ^ (((sb >> 9) & 1) << 5); R = (st >> 1) * 16 + swz / 64; C = (st & 1) * 32 + (swz % 64) / 2; }
__host__ __device__ __forceinline__ int perm32(int rho) { const int n = rho >> 4, i = rho & 15; return 8 * (i >> 2) + 4 * n + (i & 3); }

struct Unit { int pm, pn, q; };
struct Gemm { const bf16_t* A; const bf16_t* Bt; int lda, K; int a_colstep; };

__device__ __forceinline__ int tile_row0(int pm, bool ffn) { return ffn ? (pm < 65 ? 254 * pm : NPROMPT + 256 * (pm - 65)) : 256 * pm; }

struct StaticOrder {
    int nM, nN, nwg, G, c; bool ffn, samp, ksplit = false;
    __device__ void init(int nM_, int nN_, int G_, int c_, bool ffn_, bool samp_ = false) { nM = ffn_ ? 65 : nM_; nN = nN_; nwg = nM * nN; G = G_; c = c_; ffn = ffn_; samp = samp_; }
    __device__ bool next(int i, Unit& u) const {
        u.q = 0;
        if (samp) { int sidx = c - nwg % G; if (sidx < 0) sidx += G; if (i > 0 || sidx >= 4 * nN) return false; u.pm = 65 + (sidx & 3); u.pn = sidx >> 2; return true; }
        const long L = (long)i * G + c; if (L >= nwg) return false;
        int wgid = (int)L; { const int q = nwg / NXCD, r = nwg % NXCD, xcd = wgid % NXCD, off = wgid / NXCD; wgid = (xcd < r ? xcd * (q + 1) : r * (q + 1) + (xcd - r) * q) + off; }
        const int nig = WGM * nN, gid = wgid / nig, fm = gid * WGM, gsz = (nM - fm) < WGM ? (nM - fm) : WGM;
        u.pm = fm + ((wgid % nig) % gsz); u.pn = (wgid % nig) / gsz; return true;
    }
};

struct TailOrder : StaticOrder {
    __device__ __forceinline__ bool next(int i, Unit& u) const {
        const int rows1 = (G / nN) < nM ? (G / nN) : nM, n1 = rows1 * nN;
        int pm = 0, pn = 0, q = 0; bool ok = true;
        if (i == 0 && c < n1) {
            int wgid = c; { const int qq = n1 / NXCD, r = n1 % NXCD, xcd = wgid % NXCD, off = wgid / NXCD; wgid = (xcd < r ? xcd * (qq + 1) : r * (qq + 1) + (xcd - r) * qq) + off; }
            const int nig = WGM * nN, gid = wgid / nig, fm = gid * WGM, gsz = (rows1 - fm) < WGM ? (rows1 - fm) : WGM;
            pm = fm + ((wgid % nig) % gsz); pn = (wgid % nig) / gsz;
        } else {
            const int idx = i == 0 ? (c - n1) : (G - n1) + (i - 1) * G + c;
            const int sh = ksplit ? 2 : 1;
            ok = idx < ((nM - rows1) * nN << sh);
            int t = idx >> sh, sub = idx & ((1 << sh) - 1);
            if (ksplit) { const int nt2 = (nM - rows1) * nN * 2; if ((nt2 & 7) == 0 && idx < 2 * nt2) { const int hf = idx / nt2, r = idx - hf * nt2; t = r >> 1; sub = hf + 2 * (r & 1); } }
            pm = rows1 + t / nN; pn = t % nN; q = 1 + sub;
        }
        u.pm = pm; u.pn = pn; u.q = q; return ok;
    }
};

template <class Epi, bool ALIGN_EPI, bool SP2, class Ord = StaticOrder>
__device__ __forceinline__ void gemm_phase(LAS unsigned char* lds, const Gemm g, const Ord& S, const Epi& E) {
    const int tid = fresh_tid(), wid = __builtin_amdgcn_readfirstlane(tid >> 6), lane = tid & 63, wr = wid >> 2, wc = wid & 3, fr = lane & 15, fq = lane >> 4;
    int K_ = g.K, lda_ = g.lda, acs_ = g.a_colstep; asm volatile("" : "+s"(K_), "+s"(lda_), "+s"(acs_));
    const int K = K_, nt = K / BK, lda = lda_, acs = acs_;
    unsigned voffA[2], voffB[2];
#pragma unroll
    for (int i = 0; i < 2; ++i) { int R, C; stage_rc(tid * 16 + i * 8192, R, C); const int Rb = Epi::PERM ? ((R & ~31) + perm32(R & 31)) : R;
        voffA[i] = (unsigned)(R * lda + C) * 2u; voffB[i] = (unsigned)(Rb * K + C) * 2u; }
    const size_t kstep = (size_t)(BK * 2);
    const size_t hstepA = (size_t)HALF * lda * 2, hstepB = (size_t)HALF * K * 2;
    const size_t tstepB = 2 * hstepB;
    const unsigned ldsw = (unsigned)wid * 1024u;
    const int aoff = lds_byte(wr * 64 + fr, fq * 8), boff = lds_byte(wc * 32 + fr, fq * 8);
#define PG8_SA(b, h) (((b) * 2 + (h)) * HTB)
#define PG8_SB(b, h) ((4 + (b) * 2 + (h)) * HTB)
#define PG8_STAGE(bufoff, gbase, voff) do { _Pragma("unroll") for (int _i = 0; _i < 2; ++_i) \
        __builtin_amdgcn_global_load_lds((const unsigned*)((const char*)(gbase) + (voff)[_i]), (LAS unsigned*)(lds + (bufoff) + ldsw + _i * 8192), 16, 0, 0); } while (0)
#define PG8_LDA(dst, b, h) do { _Pragma("unroll") for (int m = 0; m < 4; ++m) _Pragma("unroll") for (int k = 0; k < 2; ++k) dst[m][k] = *(const LAS bf16x8*)(lds + PG8_SA(b, h) + aoff + m * 2048 + k * 1024); } while (0)
#define PG8_LDB(dst, b, h) do { _Pragma("unroll") for (int n = 0; n < 2; ++n) _Pragma("unroll") for (int k = 0; k < 2; ++k) dst[n][k] = *(const LAS bf16x8*)(lds + PG8_SB(b, h) + boff + n * 2048 + k * 1024); } while (0)
#define PG8_MMA(ai, bj, At, Bt) do { __builtin_amdgcn_s_setprio(1); _Pragma("unroll") for (int m = 0; m < 4; ++m) _Pragma("unroll") for (int n = 0; n < 2; ++n) _Pragma("unroll") for (int k = 0; k < 2; ++k) \
        acc[ai][bj][m][n] = __builtin_amdgcn_mfma_f32_16x16x32_bf16(Bt[n][k], At[m][k], acc[ai][bj][m][n], 0, 0, 0); __builtin_amdgcn_s_setprio(0); } while (0)
#define PG8_WAIT_V(n) asm volatile("s_waitcnt vmcnt(" #n ")" ::: "memory")
#define PG8_WAIT_L(n) asm volatile("s_waitcnt lgkmcnt(" #n ")" ::: "memory")
#define PG8_BAR __builtin_amdgcn_s_barrier()
#define PG8_SCHED __builtin_amdgcn_sched_barrier(0)
    Unit cur, nxt; int ui = 0;
    if (!S.next(0, cur)) return;
    f32x4 acc[2][2][4][2];
#pragma unroll
    for (int a = 0; a < 2; ++a)
#pragma unroll
        for (int b = 0; b < 2; ++b)
#pragma unroll
            for (int m = 0; m < 4; ++m)
#pragma unroll
                for (int n = 0; n < 2; ++n) acc[a][b][m][n] = (f32x4){0.f, 0.f, 0.f, 0.f};
    bf16x8 At[4][2], B0[2][2], B1[2][2];
#define PG8_ROW0(u) (tile_row0((u).pm, S.ffn) + (((u).q && (((u).q - 1) & 1)) ? HALF : 0))
#define PG8_NT(u) ((S.ksplit && (u).q) ? (nt >> 1) : nt)
#define PG8_KOFF(u) ((S.ksplit && (u).q > 2) ? (size_t)(nt >> 1) * kstep : (size_t)0)
    const char* cA = (const char*)g.A + ((size_t)PG8_ROW0(cur) * lda + (size_t)cur.pn * acs) * 2 + PG8_KOFF(cur); const char* cB = (const char*)g.Bt + (size_t)cur.pn * tstepB + PG8_KOFF(cur);
    int ntc = PG8_NT(cur);
    if constexpr (SP2) {
        PG8_STAGE(PG8_SB(0, 0), cB, voffB); PG8_STAGE(PG8_SB(0, 1), cB + hstepB, voffB); PG8_STAGE(PG8_SA(0, 0), cA, voffA); PG8_STAGE(PG8_SA(0, 1), cA + hstepA, voffA);
        if (wr == 1) PG8_BAR;
        PG8_WAIT_V(2); PG8_BAR;
        PG8_STAGE(PG8_SB(1, 0), cB + kstep, voffB); PG8_STAGE(PG8_SA(1, 0), cA + kstep, voffA); PG8_STAGE(PG8_SB(1, 1), cB + hstepB + kstep, voffB);
        PG8_WAIT_V(6); PG8_BAR;
    } else {
        PG8_STAGE(PG8_SB(0, 0), cB, voffB); PG8_STAGE(PG8_SA(0, 0), cA, voffA); PG8_STAGE(PG8_SB(0, 1), cB + hstepB, voffB); PG8_STAGE(PG8_SA(0, 1), cA + hstepA, voffA);
        if (wr == 1) PG8_BAR;
        PG8_WAIT_V(4); PG8_BAR;
        PG8_STAGE(PG8_SB(1, 0), cB + kstep, voffB); PG8_STAGE(PG8_SA(1, 0), cA + kstep, voffA); PG8_STAGE(PG8_SB(1, 1), cB + hstepB + kstep, voffB);
        PG8_WAIT_V(6); PG8_BAR;
    }
    for (;;) {
        const bool has_next = S.next(ui + 1, nxt);
        const char* nA = has_next ? (const char*)g.A + ((size_t)PG8_ROW0(nxt) * lda + (size_t)nxt.pn * acs) * 2 + PG8_KOFF(nxt) : cA; const char* nB = has_next ? (const char*)g.Bt + (size_t)nxt.pn * tstepB + PG8_KOFF(nxt) : cB;
#pragma unroll 1
        for (int t = 0; t < ntc; t += 2) {
            const bool last = (t == ntc - 2);
            const char* a1 = cA + (size_t)(t + 1) * kstep;
            const char* a2 = last ? nA : cA + (size_t)(t + 2) * kstep; const char* b2 = last ? nB : cB + (size_t)(t + 2) * kstep;
            const char* a3 = a2 + kstep; const char* b3 = b2 + kstep;
            int full = __builtin_amdgcn_readfirstlane(cur.q == 0 ? 1 : 0); asm volatile("" : "+s"(full));
            if constexpr (SP2) {
            PG8_LDB(B0, 0, 0); PG8_LDB(B1, 0, 1); PG8_SCHED; PG8_LDA(At, 0, 0); PG8_STAGE(PG8_SA(1, 1), a1 + hstepA, voffA);
            PG8_WAIT_V(8); PG8_WAIT_L(0); PG8_BAR; PG8_MMA(0, 0, At, B0); PG8_MMA(0, 1, At, B1); PG8_BAR; PG8_SCHED;
            PG8_LDA(At, 0, 1); PG8_STAGE(PG8_SB(0, 0), b2, voffB); PG8_STAGE(PG8_SB(0, 1), b2 + hstepB, voffB); PG8_STAGE(PG8_SA(0, 0), a2, voffA);
            PG8_WAIT_V(8); PG8_WAIT_L(0); PG8_BAR; if (full) { PG8_MMA(1, 0, At, B0); PG8_MMA(1, 1, At, B1); } PG8_BAR; PG8_SCHED;
            PG8_LDB(B0, 1, 0); PG8_LDB(B1, 1, 1); PG8_SCHED; PG8_LDA(At, 1, 0); PG8_STAGE(PG8_SA(0, 1), a2 + hstepA, voffA);
            PG8_WAIT_V(8); PG8_WAIT_L(0); PG8_BAR; PG8_MMA(0, 0, At, B0); PG8_MMA(0, 1, At, B1); PG8_BAR; PG8_SCHED;
            PG8_LDA(At, 1, 1); PG8_STAGE(PG8_SB(1, 0), b3, voffB); PG8_STAGE(PG8_SB(1, 1), b3 + hstepB, voffB); PG8_STAGE(PG8_SA(1, 0), a3, voffA);
            PG8_WAIT_V(8); PG8_WAIT_L(0); PG8_BAR; if (full) { PG8_MMA(1, 0, At, B0); PG8_MMA(1, 1, At, B1); } PG8_BAR; PG8_SCHED;
            } else {
            PG8_LDB(B0, 0, 0); PG8_SCHED; PG8_LDA(At, 0, 0); PG8_STAGE(PG8_SA(1, 1), a1 + hstepA, voffA);
            PG8_WAIT_L(8); PG8_BAR; PG8_WAIT_L(0); PG8_MMA(0, 0, At, B0); PG8_BAR; PG8_SCHED;
            PG8_LDB(B1, 0, 1); PG8_STAGE(PG8_SB(0, 0), b2, voffB);
            PG8_BAR; PG8_WAIT_L(0); PG8_MMA(0, 1, At, B1); PG8_BAR;
            PG8_LDA(At, 0, 1); PG8_STAGE(PG8_SA(0, 0), a2, voffA);
            PG8_BAR; PG8_WAIT_L(0); PG8_MMA(1, 0, At, B0); PG8_BAR; PG8_SCHED;
            PG8_STAGE(PG8_SB(0, 1), b2 + hstepB, voffB);
            PG8_WAIT_V(6); PG8_BAR; PG8_MMA(1, 1, At, B1); PG8_BAR;
            PG8_LDB(B0, 1, 0); PG8_SCHED; PG8_LDA(At, 1, 0); PG8_STAGE(PG8_SA(0, 1), a2 + hstepA, voffA);
            PG8_WAIT_L(8); PG8_BAR; PG8_WAIT_L(0); PG8_MMA(0, 0, At, B0); PG8_BAR; PG8_SCHED;
            PG8_LDB(B1, 1, 1); PG8_STAGE(PG8_SB(1, 0), b3, voffB);
            PG8_BAR; PG8_WAIT_L(0); PG8_MMA(0, 1, At, B1); PG8_BAR;
            PG8_LDA(At, 1, 1); PG8_STAGE(PG8_SA(1, 0), a3, voffA);
            PG8_BAR; PG8_WAIT_L(0); PG8_MMA(1, 0, At, B0); PG8_BAR; PG8_SCHED;
            PG8_STAGE(PG8_SB(1, 1), b3 + hstepB, voffB);
            PG8_WAIT_V(6); PG8_BAR; PG8_MMA(1, 1, At, B1); PG8_BAR;
            }
        }
        if constexpr (ALIGN_EPI) { if (wr == 0) PG8_BAR; }
        E(acc, cur, PG8_ROW0(cur), wr, wc, fr, fq);
        if (!has_next) break;
#pragma unroll
        for (int a = 0; a < 2; ++a)
#pragma unroll
            for (int b = 0; b < 2; ++b)
#pragma unroll
                for (int m = 0; m < 4; ++m)
#pragma unroll
                    for (int n = 0; n < 2; ++n) acc[a][b][m][n] = (f32x4){0.f, 0.f, 0.f, 0.f};
        cur = nxt; cA = nA; cB = nB; ntc = PG8_NT(cur); ++ui;
        if constexpr (ALIGN_EPI) { if (wr == 1) PG8_BAR; }
    }
    PG8_WAIT_V(0);
    if constexpr (!ALIGN_EPI) { if (wr == 0) PG8_BAR; }
    PG8_BAR;
#undef PG8_ROW0
#undef PG8_NT
#undef PG8_KOFF
#undef PG8_SA
#undef PG8_SB
#undef PG8_STAGE
#undef PG8_LDA
#undef PG8_LDB
#undef PG8_MMA
#undef PG8_WAIT_V
#undef PG8_WAIT_L
#undef PG8_BAR
#undef PG8_SCHED
}

struct EpiQKVZ {
    static constexpr bool PERM = true;
    bf16_t* qkv; bf16_t* zb; float* bg; const float* A_log; const float* dt_bias; const float* gnw;
    __device__ __forceinline__ void operator()(f32x4 (&acc)[2][2][4][2], const Unit& u, int row0t, int wr, int wc, int fr, int fq) const {
        if (u.pn == 16) {
            if (wc == 0 && fq < 2) {
                float nA[4], db[4];
#pragma unroll
                for (int e = 0; e < 4; ++e) { nA[e] = 0.f; db[e] = 0.f; }
#pragma unroll
                for (int ai = 0; ai < 2; ++ai)
#pragma unroll
                    for (int m = 0; m < 4; ++m) { const int r = row0t + wr * 64 + fr + ai * HALF + m * 16;
#pragma unroll
                        for (int n = 0; n < 2; ++n) { const f32x4 v = acc[ai][0][m][n]; f32x4 o;
                            if (fq == 0) {
#pragma unroll
                                for (int e = 0; e < 4; ++e) o[e] = 1.0f / (1.0f + __expf(-v[e])); }
                            else {
#pragma unroll
                                for (int e = 0; e < 4; ++e) { const int h = 4 * n + e; const float xx = v[e] + dt_bias[h]; const float sp = xx > 20.f ? xx : log1pf(__expf(xx)); o[e] = -__expf(A_log[h]) * sp; } }
                            *(f32x4*)(bg + (size_t)r * 16 + 8 * fq + 4 * n) = o; } }
            }
            return;
        }
        const int row0 = row0t + wr * 64 + fr; bf16_t* base; int ldc, colt;
        if (u.pn < 12) { base = qkv; ldc = CONVCH; colt = u.pn * BM; } else { base = zb; ldc = D; colt = (u.pn - 12) * BM; }
        const int col0 = colt + wc * 32 + 8 * fq;
        if (u.pn >= 12) {
            const f32x4 g0 = *(const f32x4*)(gnw + wc * 32 + 8 * fq), g1 = *(const f32x4*)(gnw + wc * 32 + 8 * fq + 4);
#pragma unroll
            for (int ai = 0; ai < 2; ++ai)
#pragma unroll
                for (int m = 0; m < 4; ++m)
#pragma unroll
                    for (int bj = 0; bj < 2; ++bj) { f32x4 v0 = acc[ai][bj][m][0], v1 = acc[ai][bj][m][1];
#pragma unroll
                        for (int e = 0; e < 4; ++e) { v0[e] = silu_f(v0[e]) * g0[e]; v1[e] = silu_f(v1[e]) * g1[e]; }
                        acc[ai][bj][m][0] = v0; acc[ai][bj][m][1] = v1; }
        }
#pragma unroll
        for (int ai = 0; ai < 2; ++ai)
#pragma unroll
            for (int m = 0; m < 4; ++m) { bf16_t* rowp = base + (size_t)(row0 + ai * HALF + m * 16) * ldc + col0;
#pragma unroll
                for (int bj = 0; bj < 2; ++bj) { const f32x4 v0 = acc[ai][bj][m][0], v1 = acc[ai][bj][m][1];
                    u32x4 w; w.x = cvt_pk_bf16(v0[0], v0[1]); w.y = cvt_pk_bf16(v0[2], v0[3]); w.z = cvt_pk_bf16(v1[0], v1[1]); w.w = cvt_pk_bf16(v1[2], v1[3]);
                    __builtin_nontemporal_store(w, (u32x4*)(rowp + bj * HALF)); } }
    }
};
template <bool FIRST> struct EpiRes {
    static constexpr bool PERM = true;
    const float* xp; const float* xs; const float* meta; bf16_t* xb; float* rss;
    float* part = nullptr; unsigned* flag = nullptr; int prow1 = 0;
    __device__ __forceinline__ void operator()(f32x4 (&acc)[2][2][4][2], const Unit& u, int row0t, int wr, int wc, int fr, int fq) const {
        if (part && u.q) {
            const int sub = u.q - 1, pi = ((u.pm - prow1) * 4 + u.pn) * 2 + (sub & 1);
            float* pp = part + (size_t)pi * (16 * 512 * 4) + ((wr * 4 + wc) * 64 + fq * 16 + fr) * 4;
            if ((sub >> 1) == 0) {
#pragma unroll
                for (int m = 0; m < 4; ++m)
#pragma unroll
                    for (int bj = 0; bj < 2; ++bj)
#pragma unroll
                        for (int n = 0; n < 2; ++n) asm volatile("global_store_dwordx4 %0, %1, off sc0 sc1" :: "v"(pp + ((m * 2 + bj) * 2 + n) * 2048), "v"(acc[0][bj][m][n]) : "memory");
                asm volatile("s_waitcnt vmcnt(0)" ::: "memory");
                if (fr == 0 && fq == 0) __hip_atomic_fetch_add(flag + pi, 1u, __ATOMIC_RELAXED, __HIP_MEMORY_SCOPE_AGENT);
                return;
            }
            { unsigned polls = 0;
              while ((unsigned)__builtin_amdgcn_readfirstlane(__hip_atomic_load(flag + pi, __ATOMIC_RELAXED, __HIP_MEMORY_SCOPE_AGENT)) < 8u) { if (++polls > (1u << 20)) break; __builtin_amdgcn_s_sleep(4); }
              __builtin_amdgcn_fence(__ATOMIC_ACQUIRE, "agent"); }
#pragma unroll
            for (int m = 0; m < 4; ++m)
#pragma unroll
                for (int bj = 0; bj < 2; ++bj)
#pragma unroll
                    for (int n = 0; n < 2; ++n) acc[0][bj][m][n] = acc[0][bj][m][n] + *(const f32x4*)(pp + ((m * 2 + bj) * 2 + n) * 2048);
        }
        const int row0 = row0t + wr * 64 + fr, col0 = u.pn * BM + wc * 32 + 8 * fq;
#pragma unroll
        for (int ai = 0; ai < 2; ++ai) { if (ai == 1 && u.q != 0) break;
#pragma unroll
            for (int m = 0; m < 4; ++m) { const int r = row0 + ai * HALF + m * 16; bf16_t* rowp = xb + (size_t)r * D + col0;
                const float* src = FIRST ? x0_row(xp, xs, meta, r) : nullptr; float ss = 0.f;
#pragma unroll
                for (int bj = 0; bj < 2; ++bj) { f32x4 b0 = (f32x4){0.f, 0.f, 0.f, 0.f}, b1 = b0;
                    if (FIRST) { if (src) { b0 = __builtin_nontemporal_load((const f32x4*)(src + col0 + bj * HALF)); b1 = __builtin_nontemporal_load((const f32x4*)(src + col0 + bj * HALF + 4)); } }
                    else { const u32x4 w = *(const u32x4*)(rowp + bj * HALF);
                        b0 = (f32x4){__uint_as_float(w.x << 16), __uint_as_float(w.x & 0xffff0000u), __uint_as_float(w.y << 16), __uint_as_float(w.y & 0xffff0000u)};
                        b1 = (f32x4){__uint_as_float(w.z << 16), __uint_as_float(w.z & 0xffff0000u), __uint_as_float(w.w << 16), __uint_as_float(w.w & 0xffff0000u)}; }
                    const f32x4 v0 = acc[ai][bj][m][0] + b0, v1 = acc[ai][bj][m][1] + b1;
                    ss += ((v0[0] * v0[0] + v0[1] * v0[1]) + (v0[2] * v0[2] + v0[3] * v0[3])) + ((v1[0] * v1[0] + v1[1] * v1[1]) + (v1[2] * v1[2] + v1[3] * v1[3]));
                    u32x4 o; o.x = cvt_pk_bf16(v0[0], v0[1]); o.y = cvt_pk_bf16(v0[2], v0[3]); o.z = cvt_pk_bf16(v1[0], v1[1]); o.w = cvt_pk_bf16(v1[2], v1[3]);
                    *(u32x4*)(rowp + bj * HALF) = o; }
                if (rss) { ss += __shfl_xor(ss, 16); ss += __shfl_xor(ss, 32); if (fq == 0) atomicAdd(rss + r, ss); }
                if (m & 1) asm volatile("" ::: "memory"); } }
    }
};
template <bool SAMPLE> struct EpiFFNUp {
    static constexpr bool PERM = true;
    bf16_t* act; const float* cw; const float* cb; const float* st; float* outp; float* outs; LAS float* bnd; const float* rss;
    __device__ __forceinline__ void prescale_publish(f32x4 (&acc)[2][2][4][2], const float (&rs)[2][4], int wr, int wc, int fr, int fq) const {
#pragma unroll
        for (int ai = 0; ai < 2; ++ai)
#pragma unroll
            for (int m = 0; m < 4; ++m) { const float r1 = rsqrtf(rs[ai][m] * (1.f / D) + EPS);
#pragma unroll
                for (int bj = 0; bj < 2; ++bj)
#pragma unroll
                    for (int n = 0; n < 2; ++n) acc[ai][bj][m][n] = acc[ai][bj][m][n] * r1; }
        if (fr >= 14) {
#pragma unroll
            for (int ai = 0; ai < 2; ++ai)
#pragma unroll
                for (int bj = 0; bj < 2; ++bj)
#pragma unroll
                    for (int n = 0; n < 2; ++n) *(LAS f32x4*)(bnd + ((ai * 2 + wr) * 2 + (fr - 14)) * 256 + bj * 128 + wc * 32 + 8 * fq + 4 * n) = acc[ai][bj][3][n];
        }
        asm volatile("s_waitcnt lgkmcnt(0)" ::: "memory"); __builtin_amdgcn_s_barrier(); asm volatile("" ::: "memory");
    }
    template <int M_> __device__ __forceinline__ f32x4 conv4(const f32x4 c4, const f32x4 pg, const LAS float* bp, int fr, const f32x4 w0, const f32x4 w1, const f32x4 w2, const f32x4 bsv, int db) const {
        f32x4 p1, p2;
        if (M_ > 0) {
#pragma unroll
            for (int e = 0; e < 4; ++e) { p1[e] = dpp_f<0x111>(dpp_r<0x121>(pg[e]), c4[e]); p2[e] = dpp_f<0x112>(dpp_r<0x122>(pg[e]), c4[e]); }
        } else {
            const f32x4 x1 = *(const LAS f32x4*)(bp + 256), x2 = *(const LAS f32x4*)(bp + (fr & 1) * 256);
#pragma unroll
            for (int e = 0; e < 4; ++e) { p1[e] = dpp_f<0x111>(x1[e], c4[e]); p2[e] = dpp_f<0x112>(x2[e], c4[e]); }
        }
        if ((unsigned)(db + 1) < 17u) { const int d = fr - db;
#pragma unroll
            for (int e = 0; e < 4; ++e) { p1[e] = d == 0 ? 0.f : p1[e]; p2[e] = (unsigned)d < 2u ? 0.f : p2[e]; } }
        f32x4 uu = bsv + w2 * c4 + w1 * p1 + w0 * p2;
        asm volatile("" : "+v"(uu));
        return uu;
    }
    __device__ __forceinline__ void prompt(f32x4 (&acc)[2][2][4][2], const Unit& u, int row0t, int wr, int wc, int fr, int fq) const {
        const int q0 = row0t / LP, rem0 = row0t - q0 * LP;
        const int rho_b = rem0 < 2 ? -rem0 : LP - rem0;
        const int lo = u.pm == 0 ? 0 : 2;
        const unsigned rowoff0 = (unsigned)(row0t + wr * 64 + fr) * (unsigned)(DFF * 2);
        int cl = wc * 32 + 8 * fq; asm volatile("" : "+v"(cl));
        const int ca = u.pn * 128 + cl;
        if (rho_b >= lo + 1 && rho_b <= 257) {
#pragma unroll
            for (int ai = 0; ai < 2; ++ai)
#pragma unroll
                for (int m = 0; m < 4; ++m) { const int g0 = ai * HALF + wr * 64 + m * 16, d0 = rho_b - 2 - g0;
                    if (d0 >= -1 && d0 <= 15) { const int tl = fr - d0;
                        if ((unsigned)tl < 2u && g0 + fr >= lo) { float* op = outp + ((size_t)q0 * 2 + tl) * DFF2 + ca;
#pragma unroll
                            for (int bj = 0; bj < 2; ++bj)
#pragma unroll
                                for (int n = 0; n < 2; ++n) *(f32x4*)(op + bj * DFF + 4 * n) = acc[ai][bj][m][n]; } } }
        }
#pragma unroll
        for (int n = 0; n < 2; ++n) {
            const unsigned cso = (unsigned)((ca + 4 * n) * 4);
            const f32x4 w0 = *(const f32x4*)((const char*)cw + cso), w1 = *(const f32x4*)((const char*)(cw + DFF2) + cso), w2 = *(const f32x4*)((const char*)(cw + 2 * DFF2) + cso), bsv = *(const f32x4*)((const char*)cb + cso);
#pragma unroll
            for (int ai = 0; ai < 2; ++ai) {
                int ps = ai * 2 + wr - 1; ps = ps < 0 ? 0 : ps;
                const LAS float* bp = bnd + (ps * 2) * 256 + cl + 4 * n;
                const int db0 = rho_b - (ai * HALF + wr * 64);
                acc[ai][0][3][n] = conv4<3>(acc[ai][0][3][n], acc[ai][0][2][n], bp, fr, w0, w1, w2, bsv, db0 - 48);
                acc[ai][0][2][n] = conv4<2>(acc[ai][0][2][n], acc[ai][0][1][n], bp, fr, w0, w1, w2, bsv, db0 - 32);
                acc[ai][0][1][n] = conv4<1>(acc[ai][0][1][n], acc[ai][0][0][n], bp, fr, w0, w1, w2, bsv, db0 - 16);
                acc[ai][0][0][n] = conv4<0>(acc[ai][0][0][n], acc[ai][0][0][n], bp, fr, w0, w1, w2, bsv, db0);
            }
        }
        asm volatile("" ::: "memory");
        f32x4 wk[4];
        u32x2 pend[4];
#pragma unroll
        for (int step = 0; step < 4; ++step) {
            const int n = (step == 1 || step == 2) ? 1 : 0, ai = step >> 1;
            f32x4 w0, w1, w2, bsv;
            if (step != 2) { const unsigned cso = (unsigned)((DFF + ca + 4 * n) * 4);
                w0 = *(const f32x4*)((const char*)cw + cso); w1 = *(const f32x4*)((const char*)(cw + DFF2) + cso); w2 = *(const f32x4*)((const char*)(cw + 2 * DFF2) + cso); bsv = *(const f32x4*)((const char*)cb + cso);
                wk[0] = w0; wk[1] = w1; wk[2] = w2; wk[3] = bsv; }
            else { w0 = wk[0]; w1 = wk[1]; w2 = wk[2]; bsv = wk[3]; }
            int ps = ai * 2 + wr - 1; ps = ps < 0 ? 0 : ps;
            const LAS float* bp = bnd + (ps * 2) * 256 + 128 + cl + 4 * n;
            const int db0 = rho_b - (ai * HALF + wr * 64);
#define FFN_GATE_STORE(M_) do { \
                const f32x4 uu = conv4<M_>(acc[ai][1][M_][n], acc[ai][1][M_ > 0 ? M_ - 1 : 0][n], bp, fr, w0, w1, w2, bsv, db0 - 16 * M_); \
                const f32x4 ua = acc[ai][0][M_][n]; \
                u32x2 w; w.x = cvt_pk_bf16(silu_f(ua[0]) * uu[0], silu_f(ua[1]) * uu[1]); w.y = cvt_pk_bf16(silu_f(ua[2]) * uu[2], silu_f(ua[3]) * uu[3]); \
                if ((step & 1) == 0) pend[M_] = w; \
                else { u32x4 o; if (n == 1) { o.x = pend[M_].x; o.y = pend[M_].y; o.z = w.x; o.w = w.y; } else { o.x = w.x; o.y = w.y; o.z = pend[M_].x; o.w = pend[M_].y; } \
                    const unsigned off = rowoff0 + (unsigned)((ai * HALF + M_ * 16) * DFF * 2) + (unsigned)(ca * 2); \
                    if (ai == 0 && M_ == 0) { if (wr != 0 || fr >= lo) *(u32x4*)((char*)act + off) = o; } \
                    else *(u32x4*)((char*)act + off) = o; } \
                __builtin_amdgcn_sched_barrier(0); } while (0)
            FFN_GATE_STORE(3); FFN_GATE_STORE(2); FFN_GATE_STORE(1); FFN_GATE_STORE(0);
#undef FFN_GATE_STORE
        }
    }
    __device__ __forceinline__ f32x4 conv4s(const f32x4 c4, const f32x4 pv, int t, const f32x4 w0, const f32x4 w1, const f32x4 w2, const f32x4 bsv) const {
        f32x4 p1, p2;
#pragma unroll
        for (int e = 0; e < 4; ++e) { p1[e] = dpp_f<0x111>(0.f, c4[e]); p2[e] = dpp_f<0x112>(0.f, c4[e]); const float q1 = dpp_f<0x101>(0.f, pv[e]);
            p1[e] = t == 0 ? q1 : p1[e]; p2[e] = t < 2 ? pv[e] : p2[e]; }
        f32x4 uu = bsv + w2 * c4 + w1 * p1 + w0 * p2;
        asm volatile("" : "+v"(uu));
        return uu;
    }
    __device__ __forceinline__ void sample(f32x4 (&acc)[2][2][4][2], const Unit& u, int row0t, int wr, int wc, int fr, int fq) const {
        const int t = fr & 7, sql = ((row0t - NPROMPT + wr * 64) >> 3) + (fr >> 3);
        const unsigned rowoff0 = (unsigned)(row0t + wr * 64 + fr) * (unsigned)(DFF * 2);
        int cl = wc * 32 + 8 * fq; asm volatile("" : "+v"(cl));
        const int ca = u.pn * 128 + cl;
        if (t >= DECS - 2) {
#pragma unroll
            for (int ai = 0; ai < 2; ++ai)
#pragma unroll
                for (int m = 0; m < 4; ++m) { const unsigned oo = (unsigned)(((sql + 16 * ai + 2 * m) * 2 + (t - (DECS - 2))) * DFF2 + ca) * 4u;
#pragma unroll
                    for (int bj = 0; bj < 2; ++bj)
#pragma unroll
                        for (int n = 0; n < 2; ++n) *(f32x4*)((char*)outs + oo + (unsigned)((bj * DFF + 4 * n) * 4)) = acc[ai][bj][m][n]; }
            asm volatile("" ::: "memory");
        }
        const unsigned stoff = (unsigned)((sql * 2 + (t & 1)) * DFF2 + ca) * 4u;
#pragma unroll
        for (int n = 0; n < 2; ++n) {
            const unsigned cso = (unsigned)((ca + 4 * n) * 4);
            const f32x4 w0 = *(const f32x4*)((const char*)cw + cso), w1 = *(const f32x4*)((const char*)(cw + DFF2) + cso), w2 = *(const f32x4*)((const char*)(cw + 2 * DFF2) + cso), bsv = *(const f32x4*)((const char*)cb + cso);
#pragma unroll
            for (int ai = 0; ai < 2; ++ai) {
#pragma unroll
                for (int mp = 0; mp < 4; mp += 4) {
                    f32x4 pv[4];
#pragma unroll
                    for (int k = 0; k < 4; ++k) { pv[k] = (f32x4){0.f, 0.f, 0.f, 0.f}; if (t < 2) pv[k] = *(const f32x4*)((const char*)st + stoff + (unsigned)(((16 * ai + 2 * (mp + k)) * 2 * DFF2 + 4 * n) * 4)); }
#pragma unroll
                    for (int k = 0; k < 4; ++k) acc[ai][0][mp + k][n] = conv4s(acc[ai][0][mp + k][n], pv[k], t, w0, w1, w2, bsv);
                    __builtin_amdgcn_sched_barrier(0);
                }
            }
        }
        asm volatile("" ::: "memory");
        f32x4 wk[4];
        u32x2 pend[4];
#pragma unroll
        for (int step = 0; step < 4; ++step) {
            const int n = (step == 1 || step == 2) ? 1 : 0, ai = step >> 1;
            f32x4 w0, w1, w2, bsv;
            if (step != 2) { const unsigned cso = (unsigned)((DFF + ca + 4 * n) * 4);
                w0 = *(const f32x4*)((const char*)cw + cso); w1 = *(const f32x4*)((const char*)(cw + DFF2) + cso); w2 = *(const f32x4*)((const char*)(cw + 2 * DFF2) + cso); bsv = *(const f32x4*)((const char*)cb + cso);
                wk[0] = w0; wk[1] = w1; wk[2] = w2; wk[3] = bsv; }
            else { w0 = wk[0]; w1 = wk[1]; w2 = wk[2]; bsv = wk[3]; }
#pragma unroll
            for (int mp = 0; mp < 4; mp += 4) {
            f32x4 pv[4];
#pragma unroll
            for (int k = 0; k < 4; ++k) { pv[k] = (f32x4){0.f, 0.f, 0.f, 0.f}; if (t < 2) pv[k] = *(const f32x4*)((const char*)st + stoff + (unsigned)(((16 * ai + 2 * (mp + k)) * 2 * DFF2 + DFF + 4 * n) * 4)); }
#pragma unroll
            for (int k = 0; k < 4; ++k) { const int m = mp + k;
                const f32x4 uu = conv4s(acc[ai][1][m][n], pv[k], t, w0, w1, w2, bsv);
                const f32x4 ua = acc[ai][0][m][n];
                u32x2 w; w.x = cvt_pk_bf16(silu_f(ua[0]) * uu[0], silu_f(ua[1]) * uu[1]); w.y = cvt_pk_bf16(silu_f(ua[2]) * uu[2], silu_f(ua[3]) * uu[3]);
                if ((step & 1) == 0) pend[m] = w;
                else { u32x4 o; if (n == 1) { o.x = pend[m].x; o.y = pend[m].y; o.z = w.x; o.w = w.y; } else { o.x = w.x; o.y = w.y; o.z = pend[m].x; o.w = pend[m].y; }
                    *(u32x4*)((char*)act + rowoff0 + (unsigned)((ai * HALF + m * 16) * DFF * 2) + (unsigned)(ca * 2)) = o; }
                __builtin_amdgcn_sched_barrier(0);
            }
            }
        }
    }
    __device__ __forceinline__ void operator()(f32x4 (&acc)[2][2][4][2], const Unit& u, int row0t, int wr, int wc, int fr, int fq) const {
        asm volatile("" : "+v"(fr), "+v"(fq));
        {
            float rs[2][4];
#pragma unroll
            for (int ai = 0; ai < 2; ++ai)
#pragma unroll
                for (int m = 0; m < 4; ++m) rs[ai][m] = rss[row0t + ai * HALF + wr * 64 + m * 16 + fr];
            prescale_publish(acc, rs, wr, wc, fr, fq);
        }
        if constexpr (!SAMPLE) prompt(acc, u, row0t, wr, wc, fr, fq); else sample(acc, u, row0t, wr, wc, fr, fq);
    }
};
}


#define MFMA16(a, b, c) __builtin_amdgcn_mfma_f32_16x16x32_bf16(a, b, c, 0, 0, 0)
constexpr int NCHUNK = 33, NITEM_P = BATCH * NCHUNK * NH  , REC_BYTES = 73728;
constexpr int REC_WN = 0, REC_QD = 16384, REC_KDT = 32768, REC_AM = 49152, REC_U = 57344, REC_DMA = 57344;
__device__ __forceinline__ float row16_sum(float v) {
    v += dpp_f<0xB1>(0.f, v); v += dpp_f<0x4E>(0.f, v); v += dpp_f<0x124>(0.f, v); v += dpp_f<0x128>(0.f, v); return v;
}
__device__ __forceinline__ bf16x8 pack8(const f32x4 a, const f32x4 b) {
    u32x4 w; w.x = cvt_pk_bf16(a[0], a[1]); w.y = cvt_pk_bf16(a[2], a[3]); w.z = cvt_pk_bf16(b[0], b[1]); w.w = cvt_pk_bf16(b[2], b[3]); return __builtin_bit_cast(bf16x8, w);
}
constexpr int P2_QN = 0, P2_KN = 17408, P2_VBT = 34816, P2_KBT = 53248, P2_LF = 71680, P2_TF = 89088, P2_TB = 106496, P2_XS = 115712, P2_G = 118784, LS = 68;

struct PrepRaw { u32x4 x[2][5]; float gi, be; };
__device__ __forceinline__ void gdn_prep_load(PrepRaw& R, int item, int b0, const bf16_t* qkv, const float* bg, int tid) {
    const int h = item & 7, c = (item >> 3) % NCHUNK, b = b0 + (item >> 3) / NCHUNK;
    const int tbase = 64 * c - 48, cc = tid & 15, i0 = (tid >> 4) * 2;
#pragma unroll
    for (int part = 0; part < 2; ++part)
#pragma unroll
        for (int j = 0; j < 5; ++j) { const int t = tbase + i0 - 3 + j;
            R.x[part][j] = (t >= 0) ? *(const u32x4*)(qkv + (size_t)(b * LP + t) * CONVCH + part * 1024 + h * 128 + 8 * cc) : (u32x4){0u, 0u, 0u, 0u}; }
    R.gi = 0.f; R.be = 0.f;
    if (tid < 64) { const int t = tbase + tid; if (t >= 0) { const float* p = bg + (size_t)(b * LP + t) * 16; R.gi = p[8 + h]; R.be = p[h]; } }
}
__device__ __forceinline__ void gdn_prep_item(LAS unsigned char* lds, int item, int b0, PrepRaw& R, int next_item, const bf16_t* qkv, const float* bg, const float* gconv_w, unsigned char* rec, float* gtarr) {
    const int tid = fresh_tid(), lane = tid & 63, wave = __builtin_amdgcn_readfirstlane(tid >> 6), g = lane >> 4, l15 = lane & 15;
    const int h = item & 7;
    LAS float* Gs = (LAS float*)(lds + P2_G); LAS float* Bs = Gs + 64; LAS float* EG = Gs + 128; LAS float* DKs = Gs + 192;
    LAS float* Lf = (LAS float*)(lds + P2_LF); LAS float* Tf = (LAS float*)(lds + P2_TF); LAS float* Xs = (LAS float*)(lds + P2_XS);
    u32x4 xv[5];
    { const int c = (item >> 3) % NCHUNK, b = b0 + (item >> 3) / NCHUNK, tbase = 64 * c - 48, cc = tid & 15, i0 = (tid >> 4) * 2;
#pragma unroll
      for (int j = 0; j < 5; ++j) { const int t = tbase + i0 - 3 + j; xv[j] = (t >= 0) ? *(const u32x4*)(qkv + (size_t)(b * LP + t) * CONVCH + 2048 + h * 128 + 8 * cc) : (u32x4){0u, 0u, 0u, 0u}; } }
    if (wave == 0) {
        float G = R.gi;
#pragma unroll
        for (int o = 1; o < 64; o <<= 1) { const float v = __shfl_up(G, o); if (lane >= o) G += v; }
        const float Gl = __shfl(G, 63);
        Gs[lane] = G; Bs[lane] = R.be; EG[lane] = __expf(G); DKs[lane] = __expf(Gl - G);
        if (lane == 0) gtarr[item] = __expf(Gl);
    }
    for (int i = tid; i < 64 * LS; i += NTHREADS) Tf[i] = 0.f;
    __syncthreads();
    {
        const int cc = tid & 15, i0 = (tid >> 4) * 2;
        const float be0 = Bs[i0], be1 = Bs[i0 + 1], eg0 = EG[i0], eg1 = EG[i0 + 1];
#pragma unroll
        for (int part = 0; part < 3; ++part) {
            const int col = part * 1024 + h * 128 + 8 * cc;
            float y0[8], y1[8];
#pragma unroll
            for (int e = 0; e < 8; ++e) { y0[e] = 0.f; y1[e] = 0.f; }
#pragma unroll
            for (int j = 0; j < 5; ++j) { const u32x4 v = part < 2 ? R.x[part < 2 ? part : 0][j] : xv[j]; const unsigned vv[4] = {v.x, v.y, v.z, v.w}; float x[8];
#pragma unroll
                for (int e = 0; e < 4; ++e) { x[2 * e] = __uint_as_float(vv[e] << 16); x[2 * e + 1] = __uint_as_float(vv[e] & 0xffff0000u); }
                if (j < 4) { const f32x4 wa = *(const f32x4*)(gconv_w + j * CONVCH + col), wb = *(const f32x4*)(gconv_w + j * CONVCH + col + 4);
#pragma unroll
                    for (int e = 0; e < 8; ++e) y0[e] += (e < 4 ? wa[e] : wb[e - 4]) * x[e]; }
                if (j > 0) { const f32x4 wa = *(const f32x4*)(gconv_w + (j - 1) * CONVCH + col), wb = *(const f32x4*)(gconv_w + (j - 1) * CONVCH + col + 4);
#pragma unroll
                    for (int e = 0; e < 8; ++e) y1[e] += (e < 4 ? wa[e] : wb[e - 4]) * x[e]; } }
            float s0 = 0.f, s1 = 0.f;
#pragma unroll
            for (int e = 0; e < 8; ++e) { y0[e] = silu_f(y0[e]); y1[e] = silu_f(y1[e]); s0 += y0[e] * y0[e]; s1 += y1[e] * y1[e]; }
            if (part < 2) {
                s0 = row16_sum(s0); s1 = row16_sum(s1);
                float sc0 = rsqrtf(s0 + EPS), sc1 = rsqrtf(s1 + EPS); if (part == 0) { sc0 *= 0.08838834764831845f; sc1 *= 0.08838834764831845f; }
#pragma unroll
                for (int e = 0; e < 8; ++e) { y0[e] *= sc0; y1[e] *= sc1; }
                LAS unsigned char* img = lds + (part == 0 ? P2_QN : P2_KN);
                u32x4 w0, w1; w0.x = cvt_pk_bf16(y0[0], y0[1]); w0.y = cvt_pk_bf16(y0[2], y0[3]); w0.z = cvt_pk_bf16(y0[4], y0[5]); w0.w = cvt_pk_bf16(y0[6], y0[7]);
                w1.x = cvt_pk_bf16(y1[0], y1[1]); w1.y = cvt_pk_bf16(y1[2], y1[3]); w1.z = cvt_pk_bf16(y1[4], y1[5]); w1.w = cvt_pk_bf16(y1[6], y1[7]);
                *(LAS u32x4*)(img + (i0 * 136 + 8 * cc) * 2) = w0; *(LAS u32x4*)(img + ((i0 + 1) * 136 + 8 * cc) * 2) = w1;
                if (part == 1) {
                    const float f0 = be0 * eg0, f1 = be1 * eg1;
#pragma unroll
                    for (int e = 0; e < 8; ++e) *(LAS unsigned*)(lds + P2_KBT + ((8 * cc + e) * 72 + i0) * 2) = cvt_pk_bf16(y0[e] * f0, y1[e] * f1);
                }
            } else {
#pragma unroll
                for (int e = 0; e < 8; ++e) *(LAS unsigned*)(lds + P2_VBT + ((8 * cc + e) * 72 + i0) * 2) = cvt_pk_bf16(y0[e] * be0, y1[e] * be1);
            }
            __builtin_amdgcn_sched_barrier(0);
        }
    }
    if (next_item >= 0) gdn_prep_load(R, next_item, b0, qkv, bg, tid);
    __syncthreads();
    {
        const f32x4 z4 = (f32x4){0.f, 0.f, 0.f, 0.f};
        {
            const int ta = wave >> 1;
#pragma unroll
            for (int q = 0; q < 2; ++q) { const int tb = 2 * (wave & 1) + q; f32x4 acc = z4;
#pragma unroll
                for (int s = 0; s < 4; ++s) { const bf16x8 af = *(const LAS bf16x8*)(lds + P2_KN + ((16 * ta + l15) * 136 + 32 * s + 8 * g) * 2), bfr = *(const LAS bf16x8*)(lds + P2_KN + ((16 * tb + l15) * 136 + 32 * s + 8 * g) * 2);
                    acc = MFMA16(af, bfr, acc); }
                const int j = 16 * tb + l15; const float Gj = Gs[j];
#pragma unroll
                for (int r = 0; r < 4; ++r) { const int i = 16 * ta + 4 * g + r; Lf[i * LS + j] = (i > j) ? Bs[i] * acc[r] * __expf(Gs[i] - Gj) : 0.f; } }
        }
        {
            const int rt = wave >> 1, s = wave & 1; f32x4 a0 = z4, a1 = z4;
#pragma unroll
            for (int ks = 0; ks < 4; ++ks) { const bf16x8 qf = *(const LAS bf16x8*)(lds + P2_QN + ((16 * rt + l15) * 136 + 32 * ks + 8 * g) * 2);
                const bf16x8 k0 = *(const LAS bf16x8*)(lds + P2_KN + ((32 * s + l15) * 136 + 32 * ks + 8 * g) * 2), k1 = *(const LAS bf16x8*)(lds + P2_KN + ((32 * s + 16 + l15) * 136 + 32 * ks + 8 * g) * 2);
                a0 = MFMA16(k0, qf, a0); a1 = MFMA16(k1, qf, a1); }
            const int i = 16 * rt + l15; const float Gi = Gs[i];
#pragma unroll
            for (int r = 0; r < 4; ++r) { const int ia = 32 * s + 4 * g + r, ib = ia + 16;
                a0[r] = (i >= ia) ? a0[r] * __expf(Gi - Gs[ia]) : 0.f; a1[r] = (i >= ib) ? a1[r] * __expf(Gi - Gs[ib]) : 0.f; }
            *(bf16x8*)(rec + REC_AM + ((rt * 2 + s) * 64 + lane) * 16) = pack8(a0, a1);
        }
    }
    __syncthreads();
    if (tid < 64) { const int blk = tid >> 4, cidx = tid & 15; float x[16];
#pragma unroll
        for (int i = 0; i < 16; ++i) x[i] = (i == cidx) ? 1.f : 0.f;
#pragma unroll
        for (int i = 1; i < 16; ++i) { float a = 0.f; const LAS float* row = Lf + (16 * blk + i) * LS + 16 * blk;
#pragma unroll
            for (int j4 = 0; j4 < (i + 3) / 4; ++j4) { const f32x4 l4 = *(const LAS f32x4*)(row + 4 * j4);
#pragma unroll
                for (int e = 0; e < 4; ++e) if (4 * j4 + e < i) a += l4[e] * x[4 * j4 + e]; }
            if (i > cidx) x[i] = -a; }
#pragma unroll
        for (int i = 0; i < 16; ++i) Tf[(16 * blk + i) * LS + 16 * blk + cidx] = x[i];
    }
    __syncthreads();
#pragma unroll 1
    for (int k = 1; k < 4; ++k) {
        const int ntask = (4 - k) * 64;
        if (tid < ntask) { const int bi = tid >> 6, r = (tid >> 2) & 15, cq = tid & 3, a = bi + k; f32x4 X = (f32x4){0.f, 0.f, 0.f, 0.f};
            for (int m = bi; m < a; ++m)
#pragma unroll
                for (int j4 = 0; j4 < 4; ++j4) { const f32x4 l4 = *(const LAS f32x4*)(Lf + (16 * a + r) * LS + 16 * m + 4 * j4);
#pragma unroll
                    for (int e = 0; e < 4; ++e) X += l4[e] * *(const LAS f32x4*)(Tf + (16 * m + 4 * j4 + e) * LS + 16 * bi + 4 * cq); }
            *(LAS f32x4*)(Xs + bi * 256 + r * 16 + 4 * cq) = X; }
        __syncthreads();
        if (tid < ntask) { const int bi = tid >> 6, r = (tid >> 2) & 15, cq = tid & 3, a = bi + k; f32x4 v = (f32x4){0.f, 0.f, 0.f, 0.f};
#pragma unroll
            for (int j4 = 0; j4 < 4; ++j4) { const f32x4 t4 = *(const LAS f32x4*)(Tf + (16 * a + r) * LS + 16 * a + 4 * j4);
#pragma unroll
                for (int e = 0; e < 4; ++e) v += t4[e] * *(const LAS f32x4*)(Xs + bi * 256 + (4 * j4 + e) * 16 + 4 * cq); }
            *(LAS f32x4*)(Tf + (16 * a + r) * LS + 16 * bi + 4 * cq) = -v; }
        __syncthreads();
    }
    for (int i = tid; i < 64 * 16; i += NTHREADS) { const int r = i >> 4, c4 = (i & 15) * 4; const f32x4 t4 = *(const LAS f32x4*)(Tf + r * LS + c4);
        u32x2 w; w.x = cvt_pk_bf16(t4[0], t4[1]); w.y = cvt_pk_bf16(t4[2], t4[3]); *(LAS u32x2*)(lds + P2_TB + (r * 72 + c4) * 2) = w; }
    __syncthreads();
    {
        const f32x4 z4 = (f32x4){0.f, 0.f, 0.f, 0.f};
#pragma unroll
        for (int rt = 0; rt < 4; ++rt) { f32x4 acc = z4;
#pragma unroll
            for (int s = 0; s < 2; ++s) { const bf16x8 tf = *(const LAS bf16x8*)(lds + P2_TB + ((16 * rt + l15) * 72 + 32 * s + 8 * g) * 2), vf = *(const LAS bf16x8*)(lds + P2_VBT + ((16 * wave + l15) * 72 + 32 * s + 8 * g) * 2);
                acc = MFMA16(tf, vf, acc); }
            u32x2 w; w.x = cvt_pk_bf16(acc[0], acc[1]); w.y = cvt_pk_bf16(acc[2], acc[3]);
            *(u32x2*)(rec + REC_U + ((rt * 8 + wave) * 64 + lane) * 8) = w; }
        const int rt = wave >> 1;
#pragma unroll
        for (int q = 0; q < 2; ++q) { const int s2 = 2 * (wave & 1) + q; f32x4 a0 = z4, a1 = z4;
#pragma unroll
            for (int s = 0; s < 2; ++s) { const bf16x8 tf = *(const LAS bf16x8*)(lds + P2_TB + ((16 * rt + l15) * 72 + 32 * s + 8 * g) * 2);
                const bf16x8 k0 = *(const LAS bf16x8*)(lds + P2_KBT + ((32 * s2 + l15) * 72 + 32 * s + 8 * g) * 2), k1 = *(const LAS bf16x8*)(lds + P2_KBT + ((32 * s2 + 16 + l15) * 72 + 32 * s + 8 * g) * 2);
                a0 = MFMA16(k0, tf, a0); a1 = MFMA16(k1, tf, a1); }
            *(bf16x8*)(rec + REC_WN + ((rt * 4 + s2) * 64 + lane) * 16) = pack8(-a0, -a1); }
    }
#pragma unroll
    for (int q = 0; q < 2; ++q) { const int task = tid + q * NTHREADS, fragi = task >> 6, ln = task & 63, lg = ln >> 4, l = ln & 15;
        const int rt = fragi >> 2, s2 = fragi & 3, i = 16 * rt + l; const float e = EG[i];
        const u32x2 lo = *(const LAS u32x2*)(lds + P2_QN + (i * 136 + 32 * s2 + 4 * lg) * 2), hi = *(const LAS u32x2*)(lds + P2_QN + (i * 136 + 32 * s2 + 16 + 4 * lg) * 2);
        const unsigned vv[4] = {lo.x, lo.y, hi.x, hi.y}; u32x4 w; unsigned ww[4];
#pragma unroll
        for (int k2 = 0; k2 < 4; ++k2) ww[k2] = cvt_pk_bf16(__uint_as_float(vv[k2] << 16) * e, __uint_as_float(vv[k2] & 0xffff0000u) * e);
        w.x = ww[0]; w.y = ww[1]; w.z = ww[2]; w.w = ww[3];
        *(u32x4*)(rec + REC_QD + (fragi * 64 + ln) * 16) = w; }
#pragma unroll
    for (int q = 0; q < 2; ++q) { const int task = tid + q * NTHREADS, fragi = task >> 6, ln = task & 63, lg = ln >> 4, l = ln & 15;
        const int dt = fragi >> 1, s = fragi & 1, dk = 16 * dt + l; float v[8];
#pragma unroll
        for (int j = 0; j < 8; ++j) { const int i = 32 * s + 4 * lg + (j & 3) + 16 * (j >> 2); v[j] = bf2f(*(const LAS bf16_t*)(lds + P2_KN + (i * 136 + dk) * 2)) * DKs[i]; }
        u32x4 w; w.x = cvt_pk_bf16(v[0], v[1]); w.y = cvt_pk_bf16(v[2], v[3]); w.z = cvt_pk_bf16(v[4], v[5]); w.w = cvt_pk_bf16(v[6], v[7]);
        *(u32x4*)(rec + REC_KDT + (fragi * 64 + ln) * 16) = w; }
    __syncthreads();
}

constexpr int P3_BUF = 0, P3_OST = 114688, P3_OSTB = 16896, P3_RSS = 148480, P3_RSSB = 2048, P3_NW = 152576;
static_assert(P3_NW + 512 <= LDS_MISC, "scan LDS map");
__device__ __forceinline__ void gdn_scan_finalize(LAS unsigned char* lds, int cf, int b, int h, int tid, const u32x4 z0, const u32x4 z1, bf16_t* zb, const float* gnorm_w) {
    const int i = tid >> 3, seg = tid & 7, t = 64 * cf - 48 + i;
    LAS unsigned char* ost = lds + P3_OST + (cf & 1) * P3_OSTB;
    const u32x2 o0 = *(const LAS u32x2*)(ost + (i * 132 + 16 * seg) * 2), o1 = *(const LAS u32x2*)(ost + (i * 132 + 16 * seg + 4) * 2),
                o2 = *(const LAS u32x2*)(ost + (i * 132 + 16 * seg + 8) * 2), o3 = *(const LAS u32x2*)(ost + (i * 132 + 16 * seg + 12) * 2);
    const unsigned oo[8] = {o0.x, o0.y, o1.x, o1.y, o2.x, o2.y, o3.x, o3.y};
    float of[16]; float ss = 0.f;
#pragma unroll
    for (int k2 = 0; k2 < 8; ++k2) { of[2 * k2] = __uint_as_float(oo[k2] << 16); of[2 * k2 + 1] = __uint_as_float(oo[k2] & 0xffff0000u); ss += of[2 * k2] * of[2 * k2] + of[2 * k2 + 1] * of[2 * k2 + 1]; }
    ss += dpp_f<0xB1>(0.f, ss); ss += dpp_f<0x4E>(0.f, ss); ss += __shfl_xor(ss, 4);
    if (t >= 0) {
        const float rstd = rsqrtf(ss * (1.f / DV) + EPS);
        bf16_t* zr = zb + (size_t)(b * LP + t) * D + h * 128 + 16 * seg;
        const unsigned zz[8] = {z0.x, z0.y, z0.z, z0.w, z1.x, z1.y, z1.z, z1.w};
        const LAS float* nw = (const LAS float*)(lds + P3_NW) + 16 * seg; unsigned res[8];
#pragma unroll
        for (int k2 = 0; k2 < 8; ++k2) { const float za = __uint_as_float(zz[k2] << 16), zc = __uint_as_float(zz[k2] & 0xffff0000u);
            res[k2] = cvt_pk_bf16(of[2 * k2] * rstd * za, of[2 * k2 + 1] * rstd * zc); }
        *(u32x4*)zr = (u32x4){res[0], res[1], res[2], res[3]}; *(u32x4*)(zr + 8) = (u32x4){res[4], res[5], res[6], res[7]};
    }
}
template <class RecFn>
__device__ __forceinline__ void gdn_scan(LAS unsigned char* lds, int bh, int b0, RecFn rec_of, const float* gtarr, bf16_t* zb, const float* gnorm_w, float* Sout, const unsigned* late_cnt, unsigned late_need, int cwait) {
    const int tid = fresh_tid(), lane = tid & 63, wave = __builtin_amdgcn_readfirstlane(tid >> 6), g = lane >> 4, l15 = lane & 15;
    const int b = bh >> 3, h = bh & 7, bl = b - b0;
    const f32x4 z4 = (f32x4){0.f, 0.f, 0.f, 0.f};
    const u32x4 zu = (u32x4){0u, 0u, 0u, 0u};
    f32x4 S[8];
#pragma unroll
    for (int dt = 0; dt < 8; ++dt) S[dt] = z4;
    u32x2 Un[4]; float gtn; u32x4 zn0 = zu, zn1 = zu, zp0 = zu, zp1 = zu;
    const int zi = tid >> 3, zseg = tid & 7;
    if (tid < DV) ((LAS float*)(lds + P3_NW))[tid] = gnorm_w[tid];
    auto late_wait = [&]() {
        if (threadIdx.x == 0) { unsigned polls = 0;
            while (__hip_atomic_load(late_cnt, __ATOMIC_RELAXED, __HIP_MEMORY_SCOPE_AGENT) < late_need) { if (++polls > (1u << 20)) break; __builtin_amdgcn_s_sleep(8); }
            __builtin_amdgcn_fence(__ATOMIC_ACQUIRE, "agent"); asm volatile("s_waitcnt vmcnt(0)" ::: "memory"); }
        __syncthreads(); };
    if (cwait == 0) late_wait();
    {
        const unsigned char* rec = rec_of((bl * NCHUNK + 0) * 8 + h);
#pragma unroll
        for (int pz = 0; pz < 7; ++pz) { const int piece = wave + 8 * pz; __builtin_amdgcn_global_load_lds((const unsigned*)(rec + piece * 1024 + lane * 16), (LAS unsigned*)(lds + P3_BUF + piece * 1024), 16, 0, 0); }
#pragma unroll
        for (int rt = 0; rt < 4; ++rt) Un[rt] = *(const u32x2*)(rec + REC_U + ((rt * 8 + wave) * 64 + lane) * 8);
        gtn = gtarr[(bl * NCHUNK + 0) * 8 + h];
        { const int t = -48 + zi; if (t >= 0) { const bf16_t* zr = zb + (size_t)(b * LP + t) * D + h * 128 + 16 * zseg; zn0 = *(const u32x4*)zr; zn1 = *(const u32x4*)(zr + 8); } }
    }
    asm volatile("s_waitcnt vmcnt(0)" ::: "memory");
    __syncthreads();
#pragma unroll 1
    for (int c = 0; c < NCHUNK; ++c) {
        if (c + 1 == cwait) late_wait();
        LAS unsigned char* buf = lds + P3_BUF + (c & 1) * REC_DMA;
        u32x2 Uc[4];
#pragma unroll
        for (int rt = 0; rt < 4; ++rt) Uc[rt] = Un[rt];
        const float gt = gtn;
        const u32x4 zf0 = zp0, zf1 = zp1;
        zp0 = zn0; zp1 = zn1;
        if (c + 1 < NCHUNK) {
            const unsigned char* rec = rec_of((bl * NCHUNK + c + 1) * 8 + h); LAS unsigned char* nb = lds + P3_BUF + ((c + 1) & 1) * REC_DMA;
#pragma unroll
            for (int pz = 0; pz < 7; ++pz) { const int piece = wave + 8 * pz; __builtin_amdgcn_global_load_lds((const unsigned*)(rec + piece * 1024 + lane * 16), (LAS unsigned*)(nb + piece * 1024), 16, 0, 0); }
#pragma unroll
            for (int rt = 0; rt < 4; ++rt) Un[rt] = *(const u32x2*)(rec + REC_U + ((rt * 8 + wave) * 64 + lane) * 8);
            gtn = gtarr[(bl * NCHUNK + c + 1) * 8 + h];
            { const int t = 64 * (c + 1) - 48 + zi; const bf16_t* zr = zb + (size_t)(b * LP + t) * D + h * 128 + 16 * zseg; zn0 = *(const u32x4*)zr; zn1 = *(const u32x4*)(zr + 8); }
        }
        if (c > 0) gdn_scan_finalize(lds, c - 1, b, h, tid, zf0, zf1, zb, gnorm_w);
        bf16x8 Sb[4];
#pragma unroll
        for (int s2 = 0; s2 < 4; ++s2) Sb[s2] = pack8(S[2 * s2], S[2 * s2 + 1]);
#define LDF(off) (*(const LAS bf16x8*)(buf + (off) + lane * 16))
#define PIN8(f) asm volatile("" : "+v"(f[0]), "+v"(f[1]), "+v"(f[2]), "+v"(f[3]), "+v"(f[4]), "+v"(f[5]), "+v"(f[6]), "+v"(f[7])); __builtin_amdgcn_sched_barrier(0)
        f32x4 av[4], ao[4];
        bf16x8 fa[8], fb[8];
#pragma unroll
        for (int s2 = 0; s2 < 4; ++s2) { fa[s2] = LDF(REC_WN + (0 * 4 + s2) * 1024); fa[4 + s2] = LDF(REC_QD + (0 * 4 + s2) * 1024); }
#pragma unroll
        for (int rt = 0; rt < 4; ++rt) {
            av[rt] = (f32x4){__uint_as_float(Uc[rt].x << 16), __uint_as_float(Uc[rt].x & 0xffff0000u), __uint_as_float(Uc[rt].y << 16), __uint_as_float(Uc[rt].y & 0xffff0000u)};
            ao[rt] = z4;
            bf16x8 (&cur)[8] = (rt & 1) ? fb : fa; bf16x8 (&nxt)[8] = (rt & 1) ? fa : fb;
            if (rt < 3) {
#pragma unroll
                for (int s2 = 0; s2 < 4; ++s2) { nxt[s2] = LDF(REC_WN + ((rt + 1) * 4 + s2) * 1024); nxt[4 + s2] = LDF(REC_QD + ((rt + 1) * 4 + s2) * 1024); }
            } else {
#pragma unroll
                for (int q = 0; q < 8; ++q) nxt[q] = LDF(REC_AM + q * 1024);
            }
            PIN8(cur);
#pragma unroll
            for (int s2 = 0; s2 < 4; ++s2) { av[rt] = MFMA16(cur[s2], Sb[s2], av[rt]); ao[rt] = MFMA16(cur[4 + s2], Sb[s2], ao[rt]); }
            __builtin_amdgcn_sched_barrier(0);
        }
        bf16x8 Vb[2];
#pragma unroll
        for (int s = 0; s < 2; ++s) Vb[s] = pack8(av[2 * s], av[2 * s + 1]);
#pragma unroll
        for (int q = 0; q < 8; ++q) fb[q] = LDF(REC_KDT + q * 1024);
        PIN8(fa);
#pragma unroll
        for (int rt = 0; rt < 4; ++rt)
#pragma unroll
            for (int s = 0; s < 2; ++s) ao[rt] = MFMA16(fa[rt * 2 + s], Vb[s], ao[rt]);
        __builtin_amdgcn_sched_barrier(0);
#pragma unroll
        for (int q = 0; q < 8; ++q) fa[q] = LDF(REC_KDT + (8 + q) * 1024);
        PIN8(fb);
#pragma unroll
        for (int dt = 0; dt < 4; ++dt) { S[dt] = S[dt] * gt;
#pragma unroll
            for (int s = 0; s < 2; ++s) S[dt] = MFMA16(fb[dt * 2 + s], Vb[s], S[dt]); }
        __builtin_amdgcn_sched_barrier(0);
        PIN8(fa);
#pragma unroll
        for (int dt = 4; dt < 8; ++dt) { S[dt] = S[dt] * gt;
#pragma unroll
            for (int s = 0; s < 2; ++s) S[dt] = MFMA16(fa[(dt - 4) * 2 + s], Vb[s], S[dt]); }
#undef LDF
#undef PIN8
        { LAS unsigned char* ost = lds + P3_OST + (c & 1) * P3_OSTB;
#pragma unroll
          for (int rt = 0; rt < 4; ++rt)
#pragma unroll
            for (int r = 0; r < 4; ++r) { const int i = 16 * rt + 4 * g + r; const float v = ao[rt][r];
                *(LAS bf16_t*)(ost + (i * 132 + 16 * wave + l15) * 2) = (bf16_t)(cvt_pk_bf16(v, 0.f) & 0xffffu); } }
        asm volatile("s_waitcnt vmcnt(0)" ::: "memory");
        __syncthreads();
    }
    gdn_scan_finalize(lds, NCHUNK - 1, b, h, tid, zp0, zp1, zb, gnorm_w);
#pragma unroll
    for (int dt = 0; dt < 8; ++dt)
#pragma unroll
        for (int r = 0; r < 4; ++r) Sout[(size_t)(16 * dt + 4 * g + r) * DV + 16 * wave + l15] = S[dt][r];
    __syncthreads();
}

constexpr int PS_QS = 0, PS_KS = 4096, PS_VS = 8192, PS_OS = 12288, PS_B = 16384, PS_SST = 16512;
__device__ __forceinline__ void gdn_sample_item(LAS unsigned char* lds, int item, const bf16_t* qkv, const float* bg, const float* gconv_w, const float* st_gconv, const float* st_grec, bf16_t* zb, const float* gnorm_w, float* srec) {
    const int tid = fresh_tid(), lane = tid & 63, wave = __builtin_amdgcn_readfirstlane(tid >> 6);
    const int sb = item >> 3, h = item & 7, rowbase = NPROMPT + sb * DECS;
    LAS float* qs = (LAS float*)(lds + PS_QS); LAS float* ks = (LAS float*)(lds + PS_KS); LAS float* vs = (LAS float*)(lds + PS_VS); LAS float* os = (LAS float*)(lds + PS_OS);
    LAS float* bs = (LAS float*)(lds + PS_B); LAS float* eas = bs + 8; LAS float* Sst = (LAS float*)(lds + PS_SST);
    const int cq = tid >> 4, dki = tid & 15;
    const float* S0 = st_grec + ((size_t)sb * NH + h) * DK * DV;
#pragma unroll
    for (int rr = 0; rr < 8; ++rr) { const int dk = (tid >> 5) + 16 * rr, c4 = 4 * (tid & 31); *(LAS f32x4*)(Sst + dk * 132 + c4) = __builtin_nontemporal_load((const f32x4*)(S0 + (size_t)dk * DV + c4)); }
    for (int task = tid; task < 768; task += NTHREADS) { const int ch = task % 384, half = task / 384, part = ch >> 7, colq = part * 1024 + h * 128 + (ch & 127);
        LAS float* dst = (part == 0 ? qs : part == 1 ? ks : vs) + (ch & 127);
        const float w0 = gconv_w[colq], w1 = gconv_w[CONVCH + colq], w2 = gconv_w[2 * CONVCH + colq], w3 = gconv_w[3 * CONVCH + colq];
        const int tb = 4 * half; float xm[3];
#pragma unroll
        for (int j = 0; j < 3; ++j) { const int tt = tb - 3 + j; xm[j] = tt >= 0 ? bf2f(qkv[(size_t)(rowbase + tt) * CONVCH + colq]) : st_gconv[((size_t)sb * 3 + (3 + tt)) * CONVCH + colq]; }
#pragma unroll
        for (int i = 0; i < 4; ++i) { const float xc = bf2f(qkv[(size_t)(rowbase + tb + i) * CONVCH + colq]);
            const float y = w0 * xm[0] + w1 * xm[1] + w2 * xm[2] + w3 * xc; xm[0] = xm[1]; xm[1] = xm[2]; xm[2] = xc; dst[(tb + i) * 128] = silu_f(y); } }
    if (tid < 8) { const float* b2 = bg + (size_t)(rowbase + tid) * 16; bs[tid] = b2[h]; eas[tid] = __expf(b2[8 + h]); }
    __syncthreads();
    if (tid < 256) { const int vec = tid >> 4, part = tid & 15; LAS float* vp = (vec < 8 ? qs + vec * 128 : ks + (vec - 8) * 128) + 8 * part;
        const f32x4 a = *(LAS f32x4*)vp, b = *(LAS f32x4*)(vp + 4);
        float ss = (a.x * a.x + a.y * a.y) + (a.z * a.z + a.w * a.w) + (b.x * b.x + b.y * b.y) + (b.z * b.z + b.w * b.w);
        ss = row16_sum(ss);
        float sc = rsqrtf(ss + EPS); if (vec < 8) sc *= 0.08838834764831845f;
        *(LAS f32x4*)vp = a * sc; *(LAS f32x4*)(vp + 4) = b * sc; }
    float Sr[4][8];
#pragma unroll
    for (int cc = 0; cc < 4; ++cc)
#pragma unroll
        for (int j = 0; j < 8; ++j) Sr[cc][j] = Sst[(8 * dki + j) * 132 + cq + 32 * cc];
    __syncthreads();
#pragma unroll 1
    for (int tt = 0; tt < DECS; ++tt) {
        const float a = eas[tt], be = bs[tt];
        const f32x4 k0 = *(const LAS f32x4*)(ks + tt * 128 + 8 * dki), k1 = *(const LAS f32x4*)(ks + tt * 128 + 8 * dki + 4);
        const f32x4 q0 = *(const LAS f32x4*)(qs + tt * 128 + 8 * dki), q1 = *(const LAS f32x4*)(qs + tt * 128 + 8 * dki + 4);
#pragma unroll
        for (int cc = 0; cc < 4; ++cc) { float part = 0.f;
#pragma unroll
            for (int j = 0; j < 8; ++j) { Sr[cc][j] *= a; part += (j < 4 ? k0[j] : k1[j - 4]) * Sr[cc][j]; }
            part = row16_sum(part);
            const float uu = be * (vs[tt * 128 + cq + 32 * cc] - part); float po = 0.f;
#pragma unroll
            for (int j = 0; j < 8; ++j) { Sr[cc][j] += (j < 4 ? k0[j] : k1[j - 4]) * uu; po += (j < 4 ? q0[j] : q1[j - 4]) * Sr[cc][j]; }
            po = row16_sum(po);
            if (dki == 0) os[tt * 128 + cq + 32 * cc] = po; }
    }
#pragma unroll
    for (int cc = 0; cc < 4; ++cc)
#pragma unroll
        for (int j = 0; j < 8; ++j) Sst[(8 * dki + j) * 132 + cq + 32 * cc] = Sr[cc][j];
    __syncthreads();
    { const int tt = wave; const float o0 = os[tt * 128 + lane], o1 = os[tt * 128 + 64 + lane];
      const float rstd = rsqrtf(wave_sum(o0 * o0 + o1 * o1) * (1.f / DV) + EPS);
      bf16_t* zr = zb + (size_t)(rowbase + tt) * D + h * 128;
      const float z0 = bf2f(zr[lane]), z1 = bf2f(zr[64 + lane]);
      zr[lane] = (bf16_t)(cvt_pk_bf16(o0 * rstd * z0, 0.f) & 0xffffu); zr[64 + lane] = (bf16_t)(cvt_pk_bf16(o1 * rstd * z1, 0.f) & 0xffffu); }
    float* So = srec + ((size_t)sb * NH + h) * DK * DV;
#pragma unroll
    for (int rr = 0; rr < 8; ++rr) { const int dk = (tid >> 5) + 16 * rr, c4 = 4 * (tid & 31); __builtin_nontemporal_store(*(const LAS f32x4*)(Sst + dk * 132 + c4), (f32x4*)(So + (size_t)dk * DV + c4)); }
    __syncthreads();
}

#define XB_TMO      128
#define XB_XCNT(j)  (256  + 64 * (j))
#define XB_XSUB(j)  (1280 + 64 * (j))
#define XB_XGEN(j)  (2304 + 64 * (j))
#define XB_TOP      3328
#define XB_TOPGEN   3392
#define XCD_BAR_WORDS 3456
#define XB_SPIN_CAP (1u << 20)
__device__ __forceinline__ unsigned xb_ld(unsigned* p)              { return __hip_atomic_load(p, __ATOMIC_RELAXED, __HIP_MEMORY_SCOPE_AGENT); }
__device__ __forceinline__ unsigned xb_add(unsigned* p, unsigned v) { return __hip_atomic_fetch_add(p, v, __ATOMIC_RELAXED, __HIP_MEMORY_SCOPE_AGENT); }
__device__ __forceinline__ unsigned xb_xcc_id() { return (unsigned)__builtin_amdgcn_s_getreg((3 << 11) | 20) & 0xFu; }
#define XB_SPIN(cond, bar) do { unsigned _sp = 0; while (cond) { __builtin_amdgcn_s_sleep(1); \
    if ((++_sp & 255u) == 0u) { if (xb_ld(&(bar)[XB_TMO])) break; if (_sp > XB_SPIN_CAP) { atomicAdd(&(bar)[XB_TMO], 1u); break; } } } } while (0)
struct XcdBarrier { unsigned* bar; unsigned x; volatile LAS unsigned* st; };
__device__ __forceinline__ XcdBarrier xcd_barrier_post(unsigned* bar, volatile LAS unsigned* st) {
    XcdBarrier b; b.bar = bar; b.x = xb_xcc_id(); b.st = st;
    if (threadIdx.x == 0) (void)xb_add(&bar[XB_XCNT(b.x)], 1u);
    return b;
}
__device__ __forceinline__ void xcd_barrier_complete(unsigned* bar, unsigned x, unsigned& nloc, unsigned& nx) {
    const unsigned G = gridDim.x * gridDim.y * gridDim.z;
    unsigned sum, cnt, mine, sp = 0u;
    for (;;) {
        sum = 0u; cnt = 0u; mine = 0u;
#pragma unroll
        for (unsigned j = 0; j < 16; ++j) { const unsigned c = xb_ld(&bar[XB_XCNT(j)]); sum += c; cnt += (c > 0u) ? 1u : 0u; mine = (j == x) ? c : mine; }
        if (sum == G) break;
        __builtin_amdgcn_s_sleep(1);
        if ((++sp & 255u) == 0u) { if (xb_ld(&bar[XB_TMO])) break; if (sp > XB_SPIN_CAP) { atomicAdd(&bar[XB_TMO], 1u); break; } }
    }
    nloc = mine > 0u ? mine : 1u; nx = cnt > 0u ? cnt : 1u;
}
__device__ __forceinline__ void xcd_barrier(const XcdBarrier& b) {
    asm volatile("s_waitcnt vmcnt(0)" ::: "memory");
    __syncthreads();
    if (threadIdx.x == 0) {
        unsigned* bar = b.bar;
        unsigned bx_ = (unsigned)__builtin_amdgcn_readfirstlane((int)xb_xcc_id()); asm volatile("" : "+s"(bx_));
        __builtin_amdgcn_s_waitcnt(0);
        unsigned nloc = b.st[0], nx = b.st[1];
        if (nloc == 0u) { xcd_barrier_complete(bar, bx_, nloc, nx); b.st[0] = nloc; b.st[1] = nx; }
        const unsigned old = xb_add(&bar[XB_XSUB(bx_)], 1u);
        const unsigned gen = old / nloc;
        if (old + 1u == (gen + 1u) * nloc) {
            __builtin_amdgcn_fence(__ATOMIC_RELEASE, "agent");
            asm volatile("s_waitcnt vmcnt(0)" ::: "memory");
            const unsigned og = xb_add(&bar[XB_TOP], 1u);
            const unsigned tg = og / nx;
            if (og + 1u == (tg + 1u) * nx) xb_add(&bar[XB_TOPGEN], 1u);
            else XB_SPIN(xb_ld(&bar[XB_TOPGEN]) == tg, bar);
            __builtin_amdgcn_fence(__ATOMIC_ACQUIRE, "agent");
            xb_add(&bar[XB_XGEN(bx_)], 1u);
            asm volatile("s_waitcnt vmcnt(0)" ::: "memory");
        } else {
            XB_SPIN(xb_ld(&bar[XB_XGEN(bx_)]) == gen, bar);
            __builtin_amdgcn_fence(__ATOMIC_ACQUIRE, "agent");
            asm volatile("s_waitcnt vmcnt(0)" ::: "memory");
        }
    }
    __syncthreads();
}

__device__ __forceinline__ void transpose_item(const float* W, int ldn, int K, bf16_t* WT, int dst_row0, const float* rowscale, LAS float* scr, int kb, int n0, int lane, const float* kscale = nullptr) {
    const int k0 = 64 * kb;
#pragma unroll 8
    for (int i = 0; i < 32; ++i) { const int kk = 2 * i + (lane >> 5); scr[kk * 33 + (lane & 31)] = __builtin_nontemporal_load(W + (size_t)(k0 + kk) * ldn + n0 + (lane & 31)); }
    asm volatile("s_waitcnt lgkmcnt(0)" ::: "memory");
    const int c = lane & 7;
    float ks[8];
#pragma unroll
    for (int e = 0; e < 8; ++e) ks[e] = kscale ? kscale[k0 + 8 * c + e] : 1.0f;
#pragma unroll
    for (int j = 0; j < 4; ++j) { const int n = (lane >> 3) + 8 * j; const LAS float* s = scr + (8 * c) * 33 + n; const float sc = rowscale ? rowscale[dst_row0 + n] : 1.0f;
        u32x4 o; o.x = cvt_pk_bf16(s[0 * 33] * sc * ks[0], s[1 * 33] * sc * ks[1]); o.y = cvt_pk_bf16(s[2 * 33] * sc * ks[2], s[3 * 33] * sc * ks[3]); o.z = cvt_pk_bf16(s[4 * 33] * sc * ks[4], s[5 * 33] * sc * ks[5]); o.w = cvt_pk_bf16(s[6 * 33] * sc * ks[6], s[7 * 33] * sc * ks[7]);
        *(u32x4*)(WT + (size_t)(dst_row0 + n) * K + k0 + 8 * c) = o; }
    asm volatile("s_waitcnt lgkmcnt(0)" ::: "memory");
}


__device__ __forceinline__ unsigned char* gdn_rec(unsigned char* ws, float* out, int slot) {
    return slot < N_REC_WS ? ws + WS_R1 + (size_t)slot * REC_BYTES : (unsigned char*)out + (size_t)(slot - N_REC_WS) * REC_BYTES;
}
__device__ __forceinline__ void gdn_all(LAS unsigned char* lds, const XcdBarrier& xbar, const int G, const int bx, unsigned char* ws, float* out, const bf16_t* qkv, const float* bg, const float* gconv_w,
                                        float* gtarr, bf16_t* zb, const float* gnorm_w, const float* st_gconv, const float* st_grec) {
    const int nfull = NITEM_P / G, nlate = NITEM_P - nfull * G;
    unsigned* late_cnt = (unsigned*)(ws + WS_CTL) + 8192 + 1024;
    {
        { PrepRaw R; if (nfull > 0) gdn_prep_load(R, bx, 0, qkv, bg, fresh_tid());
          for (int k = 0; k < nfull; ++k) { const int item = bx + k * G; gdn_prep_item(lds, item, 0, R, k + 1 < nfull ? item + G : -1, qkv, bg, gconv_w, gdn_rec(ws, out, item), gtarr); } }
        {
            const int tid = fresh_tid();
            const int gt = bx * NTHREADS + tid, NGT = G * NTHREADS;
            for (int i = gt; i < (BATCH + DECB) * 3 * CONVCH; i += NGT) { const int c = i % CONVCH, j = (i / CONVCH) % 3, seq = i / (3 * CONVCH);
                if (seq < BATCH) out[O_PCONV + ((size_t)seq * 3 + j) * CONVCH + c] = bf2f(qkv[(size_t)(seq * LP + LP - 3 + j) * CONVCH + c]);
                else { const int sb = seq - BATCH; out[O_SCONV + ((size_t)sb * 3 + j) * CONVCH + c] = bf2f(qkv[(size_t)(NPROMPT + sb * DECS + DECS - 3 + j) * CONVCH + c]); } }
        }
    }
    xcd_barrier(xbar);
    if (nlate > 0 && bx >= G - nlate) {
        const int item = nfull * G + (bx - (G - nlate)); PrepRaw R; gdn_prep_load(R, item, 0, qkv, bg, fresh_tid());
        gdn_prep_item(lds, item, 0, R, -1, qkv, bg, gconv_w, gdn_rec(ws, out, item), gtarr);
        asm volatile("s_waitcnt vmcnt(0)" ::: "memory"); __syncthreads();
        if (threadIdx.x == 0) { __builtin_amdgcn_fence(__ATOMIC_RELEASE, "agent"); asm volatile("s_waitcnt vmcnt(0)" ::: "memory"); __hip_atomic_fetch_add(late_cnt, 1u, __ATOMIC_RELAXED, __HIP_MEMORY_SCOPE_AGENT); }
    }
    {
        auto rec_of = [=](int slot) -> const unsigned char* { return gdn_rec(ws, out, slot); };
        if (bx < 64) { const int cw = nfull * G / 8 - (bx >> 3) * NCHUNK;
            gdn_scan(lds, bx, 0, rec_of, gtarr, zb, gnorm_w, out + O_PREC + (size_t)bx * DK * DV, late_cnt, (unsigned)nlate, nlate > 0 ? (cw < 0 ? 0 : cw) : NCHUNK + 1); }
        else for (int it = bx - 64; it < DECB * NH; it += G - 64) gdn_sample_item(lds, it, qkv, bg, gconv_w, st_gconv, st_grec, zb, gnorm_w, out + O_SREC);
    }
    xcd_barrier(xbar);
}

struct Params {
    const float* in[22];
    float* out; unsigned char* ws;
};

__device__ __forceinline__ void rownorm_to_bf16(const float* xrow, const float* w, bf16_t* orow, int lane) {
    const f32x4* xr = (const f32x4*)xrow + lane; const f32x4* wr4 = (const f32x4*)w + lane;
    f32x4 v[4]; float s = 0.f;
#pragma unroll
    for (int j = 0; j < 4; ++j) { v[j] = xr[64 * j]; s += (v[j].x * v[j].x + v[j].y * v[j].y) + (v[j].z * v[j].z + v[j].w * v[j].w); }
    const float rstd = rsqrtf(wave_sum(s) * (1.f / D) + EPS);
    unsigned long long* o8 = (unsigned long long*)orow + lane;
#pragma unroll
    for (int j = 0; j < 4; ++j) { const f32x4 ww = wr4[64 * j]; const f32x4 h = v[j] * rstd * ww;
        o8[64 * j] = (unsigned long long)cvt_pk_bf16(h.x, h.y) | ((unsigned long long)cvt_pk_bf16(h.z, h.w) << 32); }
}

template <int WIN, int RUN> __device__ __forceinline__ void pool_run(const bf16_t* xb, const float* rss1, const float* nmw, bf16_t* pb, int r0, int t0, int c) {
    constexpr int NB = WIN - 1, NR = NB + RUN;
    u32x4 raw[NR]; float rsv[NR];
#pragma unroll
    for (int q = 0; q < NR; ++q) { raw[q] = (u32x4){0u, 0u, 0u, 0u}; rsv[q] = 0.f;
        if (q >= NB || t0 + q - NB >= 0) { raw[q] = *(const u32x4*)(xb + (size_t)(r0 + q - NB) * D + c); rsv[q] = rss1[r0 + q - NB]; } }
    float w8[8]; { const f32x4 a = *(const f32x4*)(nmw + c), b = *(const f32x4*)(nmw + c + 4); w8[0] = a[0]; w8[1] = a[1]; w8[2] = a[2]; w8[3] = a[3]; w8[4] = b[0]; w8[5] = b[1]; w8[6] = b[2]; w8[7] = b[3]; }
#define POOL_H(dst, q_) do { const float _rs = rsqrtf(rsv[q_] * (1.f / D) + EPS); const unsigned _vv[4] = {raw[q_].x, raw[q_].y, raw[q_].z, raw[q_].w}; \
        _Pragma("unroll") for (int _e = 0; _e < 4; ++_e) { dst[2 * _e] = __uint_as_float(_vv[_e] << 16) * _rs * w8[2 * _e]; dst[2 * _e + 1] = __uint_as_float(_vv[_e] & 0xffff0000u) * _rs * w8[2 * _e + 1]; } } while (0)
    float acc8[8];
#pragma unroll
    for (int e = 0; e < 8; ++e) acc8[e] = 0.f;
#pragma unroll
    for (int q = NB - 1; q >= 0; --q) { float h8[8]; POOL_H(h8, q);
#pragma unroll
        for (int e = 0; e < 8; ++e) acc8[e] += h8[e]; }
#pragma unroll
    for (int k = 0; k < RUN; ++k) { const int t = t0 + k;
        float h8[8]; POOL_H(h8, NB + k);
#pragma unroll
        for (int e = 0; e < 8; ++e) acc8[e] += h8[e];
        const int cnt = WIN < t + 1 ? WIN : t + 1; const float inv = 1.0f / (float)cnt;
        u32x4 w; w.x = cvt_pk_bf16(acc8[0] * inv - h8[0], acc8[1] * inv - h8[1]); w.y = cvt_pk_bf16(acc8[2] * inv - h8[2], acc8[3] * inv - h8[3]);
        w.z = cvt_pk_bf16(acc8[4] * inv - h8[4], acc8[5] * inv - h8[5]); w.w = cvt_pk_bf16(acc8[6] * inv - h8[6], acc8[7] * inv - h8[7]);
        *(u32x4*)(pb + (size_t)(r0 + k) * D + c) = w;
        { float o8[8]; POOL_H(o8, k);
#pragma unroll
          for (int e = 0; e < 8; ++e) acc8[e] -= o8[e]; }
    }
#undef POOL_H
}

template <int WIN> __device__ __forceinline__ void pool_sample(const bf16_t* xb, const float* rss1, const float* nmw, const float* st_pool, bf16_t* pb, int r, int c) {
    const int sq = (r - NPROMPT) >> 3, t = (r - NPROMPT) & 7;
    float w8[8]; { const f32x4 a = *(const f32x4*)(nmw + c), b = *(const f32x4*)(nmw + c + 4); w8[0] = a[0]; w8[1] = a[1]; w8[2] = a[2]; w8[3] = a[3]; w8[4] = b[0]; w8[5] = b[1]; w8[6] = b[2]; w8[7] = b[3]; }
    float acc8[8], h8[8];
#pragma unroll
    for (int e = 0; e < 8; ++e) { acc8[e] = 0.f; h8[e] = 0.f; }
#pragma unroll
    for (int j = 0; j < WIN; ++j) {
        const int tt = t - j;
        if (j < 8 && tt >= 0) { const u32x4 v = *(const u32x4*)(xb + (size_t)(r - j) * D + c); const float rs = rsqrtf(rss1[r - j] * (1.f / D) + EPS); const unsigned vv[4] = {v.x, v.y, v.z, v.w};
#pragma unroll
            for (int e = 0; e < 4; ++e) { const float a = __uint_as_float(vv[e] << 16) * rs * w8[2 * e], b = __uint_as_float(vv[e] & 0xffff0000u) * rs * w8[2 * e + 1];
                acc8[2 * e] += a; acc8[2 * e + 1] += b; if (j == 0) { h8[2 * e] = a; h8[2 * e + 1] = b; } } }
        else { const float* sp = st_pool + ((size_t)sq * 15 + (15 + tt)) * D + c; const f32x4 a = *(const f32x4*)sp, b = *(const f32x4*)(sp + 4);
#pragma unroll
            for (int e = 0; e < 4; ++e) { acc8[e] += a[e]; acc8[4 + e] += b[e]; } }
    }
    const float inv = 1.0f / (float)WIN;
    u32x4 w; w.x = cvt_pk_bf16(acc8[0] * inv - h8[0], acc8[1] * inv - h8[1]); w.y = cvt_pk_bf16(acc8[2] * inv - h8[2], acc8[3] * inv - h8[3]);
    w.z = cvt_pk_bf16(acc8[4] * inv - h8[4], acc8[5] * inv - h8[5]); w.w = cvt_pk_bf16(acc8[6] * inv - h8[6], acc8[7] * inv - h8[7]);
    *(u32x4*)(pb + (size_t)r * D + c) = w;
}

__global__ void __launch_bounds__(NTHREADS, 2) fwd_megakernel(Params p) {
    extern __shared__ __attribute__((aligned(16))) unsigned char lds_raw[];
    LAS unsigned char* lds = (LAS unsigned char*)lds_raw;
    cg::grid_group grid = cg::this_grid();
    if (threadIdx.x < 2) ((volatile LAS unsigned*)(lds + LDS_MISC))[threadIdx.x] = 0u;
    __syncthreads();
    const XcdBarrier xbar = xcd_barrier_post((unsigned*)(p.ws + WS_CTL) + 1024, (volatile LAS unsigned*)(lds + LDS_MISC));
#define GRID_SYNC() xcd_barrier(xbar)
    const int G = gridDim.x, bx = blockIdx.x, NGW = G * NWAVES;
#define PHASE_IDS() const int tid = fresh_tid(), lane = tid & 63, wave = __builtin_amdgcn_readfirstlane(tid >> 6), gw = bx * NWAVES + wave; (void)lane; (void)gw
    unsigned char* ws = p.ws;
    const float* x_prompt = p.in[0]; const float* x_sample = p.in[1]; const float* st_gconv = p.in[2]; const float* st_grec = p.in[3]; const float* st_pool = p.in[4]; const float* st_ffn = p.in[5];
    const float* meta = p.in[6]; const float* norm_mix = p.in[7]; const float* norm_ffn = p.in[8]; const float* w_in = p.in[9]; const float* gconv_w = p.in[10]; const float* A_log = p.in[11];
    const float* dt_bias = p.in[12]; const float* gnorm_w = p.in[13]; const float* w_out = p.in[14]; const float* pool_w = p.in[15]; const float* pool_scale = p.in[16]; const float* w_up = p.in[17];
    const float* fconv_w = p.in[18]; const float* fconv_b = p.in[19]; const float* w_down = p.in[20]; const float* norm_final = p.in[21];
    float* out = p.out;
    bf16_t* Win_t = (bf16_t*)(ws + WS_WIN); bf16_t* Wout_t = (bf16_t*)(ws + WS_WOUT); float* bg = (float*)(ws + WS_BG); bf16_t* hb0 = (bf16_t*)(ws + WS_HB0); bf16_t* xb = (bf16_t*)(ws + WS_XB); float* rss = (float*)(ws + WS_RSS);
    bf16_t* qkv = (bf16_t*)(ws + WS_QKV); bf16_t* zb = (bf16_t*)(ws + WS_Z); float* gtarr = (float*)(ws + WS_GT);
    bf16_t* actb = (bf16_t*)(ws + WS_ACT); bf16_t* Wup_t = (bf16_t*)(ws + WS_WUP); bf16_t* Wdn_t = (bf16_t*)(ws + WS_WDN); bf16_t* Wp_t = (bf16_t*)(ws + WS_WP);
    bf16_t* pb = actb;

    {
        PHASE_IDS();
        for (int i = bx * NTHREADS + tid; i < 3 * TP; i += G * NTHREADS) rss[i] = 0.f;
        LAS float* scr = (LAS float*)(lds + wave * 16384);
        constexpr int I_IN = 16 * 128, I_OUT = 16 * 32, I_X = 16;
        for (int it = gw; it < I_IN + I_OUT + I_X; it += NGW) {
            if (it < I_IN) { const int kb = it / 128, nb = it % 128; transpose_item(w_in, GPROJ, D, Win_t, 32 * nb, nullptr, scr, kb, 32 * nb, lane); }
            else if (it < I_IN + I_OUT) { const int r = it - I_IN, kb = r / 32, nb = r % 32; transpose_item(w_out, D, D, Wout_t, 32 * nb, nullptr, scr, kb, 32 * nb, lane); }
            else { const int kb = it - I_IN - I_OUT, k0 = 64 * kb;
#pragma unroll 8
                for (int i = 0; i < 32; ++i) { const int kk = 2 * i + (lane >> 5), n = lane & 31; scr[kk * 33 + n] = n < 16 ? w_in[(size_t)(k0 + kk) * GPROJ + 4096 + n] : 0.f; }
                asm volatile("s_waitcnt lgkmcnt(0)" ::: "memory");
                const int c = lane & 7;
#pragma unroll
                for (int j = 0; j < 4; ++j) { const int n = (lane >> 3) + 8 * j; const LAS float* sp = scr + (8 * c) * 33 + n;
                    u32x4 o; o.x = cvt_pk_bf16(sp[0 * 33], sp[1 * 33]); o.y = cvt_pk_bf16(sp[2 * 33], sp[3 * 33]); o.z = cvt_pk_bf16(sp[4 * 33], sp[5 * 33]); o.w = cvt_pk_bf16(sp[6 * 33], sp[7 * 33]);
                    *(u32x4*)(Win_t + (size_t)(4096 + n) * D + k0 + 8 * c) = o; }
                asm volatile("s_waitcnt lgkmcnt(0)" ::: "memory"); }
        }
        const f32x4* nw4 = (const f32x4*)norm_mix + lane;
        const int n2 = (I_IN + I_OUT + I_X > NGW && I_IN + I_OUT + I_X < 2 * NGW) ? I_IN + I_OUT + I_X - NGW : 0, rs = NGW - n2, r0w = gw - n2;
        if (r0w >= 0) {
        f32x4 nv[4], nv2[4];
        { const float* xrow = r0w < TP ? x0_row(x_prompt, x_sample, meta, r0w) : nullptr;
#pragma unroll
            for (int j = 0; j < 4; ++j) nv[j] = xrow ? __builtin_nontemporal_load((const f32x4*)xrow + lane + 64 * j) : (f32x4){0.f, 0.f, 0.f, 0.f}; }
        { const float* xrow = r0w + rs < TP ? x0_row(x_prompt, x_sample, meta, r0w + rs) : nullptr;
#pragma unroll
            for (int j = 0; j < 4; ++j) nv2[j] = xrow ? __builtin_nontemporal_load((const f32x4*)xrow + lane + 64 * j) : (f32x4){0.f, 0.f, 0.f, 0.f}; }
        for (int r = r0w; r < TP; r += rs) {
            f32x4 v[4];
#pragma unroll
            for (int j = 0; j < 4; ++j) { v[j] = nv[j]; nv[j] = nv2[j]; }
            if (r + 2 * rs < TP) { const float* xrow = x0_row(x_prompt, x_sample, meta, r + 2 * rs);
#pragma unroll
                for (int j = 0; j < 4; ++j) nv2[j] = xrow ? __builtin_nontemporal_load((const f32x4*)xrow + lane + 64 * j) : (f32x4){0.f, 0.f, 0.f, 0.f}; }
            float ssq = 0.f;
#pragma unroll
            for (int j = 0; j < 4; ++j) ssq += (v[j].x * v[j].x + v[j].y * v[j].y) + (v[j].z * v[j].z + v[j].w * v[j].w);
            const float rstd = rsqrtf(wave_sum(ssq) * (1.f / D) + EPS);
            unsigned long long* o8 = (unsigned long long*)(hb0 + (size_t)r * D) + lane;
#pragma unroll
            for (int j = 0; j < 4; ++j) { const f32x4 h = v[j] * rstd * nw4[64 * j];
                o8[64 * j] = (unsigned long long)cvt_pk_bf16(h.x, h.y) | ((unsigned long long)cvt_pk_bf16(h.z, h.w) << 32); }
        }
        }
    }
    GRID_SYNC();

    {
        pg8::Gemm g{hb0, Win_t, D, D, 0}; pg8::StaticOrder S; S.init(69, 17, G, bx, false);
        pg8::EpiQKVZ E{qkv, zb, bg, A_log, dt_bias, gnorm_w};
        for (int rep = 0; rep < REP_G1; ++rep) pg8::gemm_phase<pg8::EpiQKVZ, true, true>(lds, g, S, E);
    }
    GRID_SYNC();

    gdn_all(lds, xbar, G, bx, ws, out, qkv, bg, gconv_w, gtarr, zb, gnorm_w, st_gconv, st_grec);

    {
        PHASE_IDS();
        LAS float* scr = (LAS float*)(lds + wave * 16384);
        constexpr int I_UP = 16 * 176, I_DN = 44 * 32, I_P = 4 * 8;
        constexpr int NIT = 2 * I_UP + 2 * I_DN + 4 * I_P;
        for (int it = gw; it < NIT; it += NGW) {
            int r = it;
            if (r < 2 * I_UP) { const int l = r / I_UP; r -= l * I_UP; const int kb = r / 176, nb = r % 176, n0 = 32 * nb;
                const int bj = n0 / DFF, rem = n0 - bj * DFF, pnn = rem >> 7, c0 = rem & 127;
                transpose_item(w_up + (size_t)l * D * DFF2, DFF2, D, Wup_t + (size_t)l * DFF2 * D, pnn * 256 + bj * 128 + c0, nullptr, scr, kb, n0, lane, norm_ffn + l * D); continue; }
            r -= 2 * I_UP;
            if (r < 2 * I_DN) { const int l = r / I_DN; r -= l * I_DN; const int kb = r / 32, nb = r % 32;
                transpose_item(w_down + (size_t)l * DFF * D, D, DFF, Wdn_t + (size_t)l * D * DFF, 32 * nb, nullptr, scr, kb, 32 * nb, lane); continue; }
            r -= 2 * I_DN;
            { const int gi = r / I_P; r -= gi * I_P; const int kb = r / 8, nb = r % 8;
              transpose_item(pool_w + (size_t)gi * 256 * 256, 256, 256, Wp_t + (size_t)gi * 256 * 256, 32 * nb, pool_scale + gi * 256, scr, kb, 32 * nb, lane); }
        }
        __syncthreads();
    }
    {
        pg8::Gemm g{zb, Wout_t, D, D, 0}; pg8::TailOrder S; S.init(69, 4, G, bx, false);
        pg8::EpiRes<true> E{x_prompt, x_sample, meta, xb, rss};
        pg8::gemm_phase<pg8::EpiRes<true>, true, true, pg8::TailOrder>(lds, g, S, E);
    }
    GRID_SYNC();

    for (int layer = 0; layer < 2; ++layer) {
        {
            pg8::Gemm g{xb, Wup_t + (size_t)layer * DFF2 * D, D, D, 0}; pg8::StaticOrder S; S.init(69, 22, G, bx, true);
            pg8::EpiFFNUp<false> E{actb, fconv_w + (size_t)layer * 3 * DFF2, fconv_b + (size_t)layer * DFF2, st_ffn + (size_t)layer * DECB * 2 * DFF2,
                            out + O_PFFN + (size_t)layer * BATCH * 2 * DFF2, out + O_SFFN + (size_t)layer * DECB * 2 * DFF2, (LAS float*)(lds + LDS_BND), rss + (layer == 0 ? 0 : 2 * TP)};
            pg8::gemm_phase<pg8::EpiFFNUp<false>, true, true>(lds, g, S, E);
            pg8::StaticOrder S2; S2.init(69, 22, G, bx, true, true);
            pg8::EpiFFNUp<true> E2{E.act, E.cw, E.cb, E.st, E.outp, E.outs, E.bnd, E.rss};
            pg8::gemm_phase<pg8::EpiFFNUp<true>, true, true>(lds, g, S2, E2);
        }
        GRID_SYNC();
        {
            pg8::Gemm g{actb, Wdn_t + (size_t)layer * D * DFF, DFF, DFF, 0}; pg8::TailOrder S; S.init(69, 4, G, bx, false); S.ksplit = true;
            pg8::EpiRes<false> E{nullptr, nullptr, nullptr, xb, layer == 0 ? rss + TP : nullptr};
            E.part = (float*)(ws + WS_KSP); E.flag = (unsigned*)(ws + WS_CTL) + 8192 + layer * 256; E.prow1 = (G / 4) < 69 ? (G / 4) : 69;
            pg8::gemm_phase<pg8::EpiRes<false>, true, true, pg8::TailOrder>(lds, g, S, E);
        }
        GRID_SYNC();
        if (layer == 0) {
            {
                PHASE_IDS();
                const int gt = bx * NTHREADS + tid, NGT = G * NTHREADS;
                const float* rss1 = rss + TP; const float* nmw = norm_mix + D;
                for (int wi = gw; wi < (NPROMPT / 32) * 4; wi += NGW) {
                    const int cg = wi & 3, rr = (wi >> 2) * 2 + (lane >> 5), c = cg * 256 + (lane & 31) * 8;
                    const int sq = rr / (LP / 16), t0 = (rr - sq * (LP / 16)) * 16, r0 = sq * LP + t0;
                    if (cg == 0) pool_run<2, 16>(xb, rss1, nmw, pb, r0, t0, c); else if (cg == 1) pool_run<4, 16>(xb, rss1, nmw, pb, r0, t0, c);
                    else if (cg == 2) pool_run<8, 16>(xb, rss1, nmw, pb, r0, t0, c);
                    else { pool_run<16, 8>(xb, rss1, nmw, pb, r0, t0, c); pool_run<16, 8>(xb, rss1, nmw, pb, r0 + 8, t0 + 8, c); }
                }
                for (int wi = gw; wi < (NSAMP / 2) * 4; wi += NGW) {
                    const int cg = wi & 3, r = NPROMPT + (wi >> 2) * 2 + (lane >> 5), c = cg * 256 + (lane & 31) * 8;
                    if (cg == 0) pool_sample<2>(xb, rss1, nmw, st_pool, pb, r, c); else if (cg == 1) pool_sample<4>(xb, rss1, nmw, st_pool, pb, r, c);
                    else if (cg == 2) pool_sample<8>(xb, rss1, nmw, st_pool, pb, r, c); else pool_sample<16>(xb, rss1, nmw, st_pool, pb, r, c);
                }
                for (int i = gt; i < (BATCH + DECB) * 15 * (D / 8); i += NGT) { const int c = (i & 127) * 8, j = (i >> 7) % 15, seq = (i >> 7) / 15;
                    int r = -1;
                    if (seq < BATCH) r = seq * LP + LP - 15 + j; else if (j >= 7) r = NPROMPT + (seq - BATCH) * DECS + (j - 7);
                    f32x4 o0, o1;
                    if (r >= 0) { const u32x4 v = *(const u32x4*)(xb + (size_t)r * D + c); const float rs = rsqrtf(rss1[r] * (1.f / D) + EPS); const f32x4 wa = *(const f32x4*)(nmw + c), wb = *(const f32x4*)(nmw + c + 4);
                        o0 = (f32x4){__uint_as_float(v.x << 16), __uint_as_float(v.x & 0xffff0000u), __uint_as_float(v.y << 16), __uint_as_float(v.y & 0xffff0000u)} * rs * wa;
                        o1 = (f32x4){__uint_as_float(v.z << 16), __uint_as_float(v.z & 0xffff0000u), __uint_as_float(v.w << 16), __uint_as_float(v.w & 0xffff0000u)} * rs * wb; }
                    else { const float* sp = st_pool + ((size_t)(seq - BATCH) * 15 + 8 + j) * D + c; o0 = *(const f32x4*)sp; o1 = *(const f32x4*)(sp + 4); }
                    float* op = (seq < BATCH) ? out + O_PPOOL + ((size_t)seq * 15 + j) * D + c : out + O_SPOOL + ((size_t)(seq - BATCH) * 15 + j) * D + c;
                    *(f32x4*)op = o0; *(f32x4*)(op + 4) = o1; }
            }
            GRID_SYNC();
            {
                pg8::Gemm g{pb, Wp_t, D, 256, 256}; pg8::TailOrder S; S.init(69, 4, G, bx, false);
                pg8::EpiRes<false> E{nullptr, nullptr, nullptr, xb, rss + 2 * TP};
                pg8::gemm_phase<pg8::EpiRes<false>, true, true, pg8::TailOrder>(lds, g, S, E);
            }
            GRID_SYNC();
        }
    }

    { PHASE_IDS();
    auto ld_row = [&](int r, u32x4 (&w)[2]) { if (r < T) { const u32x4* xr = (const u32x4*)(xb + (size_t)r * D) + lane; w[0] = xr[0]; w[1] = xr[64]; } };
    u32x4 nw[2] = {(u32x4){0u, 0u, 0u, 0u}, (u32x4){0u, 0u, 0u, 0u}}; ld_row(gw, nw);
    for (int r = gw; r < T; r += NGW) {
        u32x4 cw2[2] = {nw[0], nw[1]};
        ld_row(r + NGW, nw);
        float* dst;
        if (r < NPROMPT) { const int b = r / LP, t = r - b * LP; if (t < NMETA) continue; dst = out + O_YP + ((size_t)b * SEQ + (t - NMETA)) * D; }
        else dst = out + O_YS + (size_t)(r - NPROMPT) * D;
        float f[2][8]; float s = 0.f;
#pragma unroll
        for (int j = 0; j < 2; ++j) { const unsigned ww[4] = {cw2[j].x, cw2[j].y, cw2[j].z, cw2[j].w};
#pragma unroll
            for (int e = 0; e < 4; ++e) { f[j][2 * e] = __uint_as_float(ww[e] << 16); f[j][2 * e + 1] = __uint_as_float(ww[e] & 0xffff0000u); s += f[j][2 * e] * f[j][2 * e] + f[j][2 * e + 1] * f[j][2 * e + 1]; } }
        const float rstd = rsqrtf(wave_sum(s) * (1.f / D) + EPS);
#pragma unroll
        for (int j = 0; j < 2; ++j) { const int c = 8 * lane + 512 * j; const f32x4 wa = *(const f32x4*)(norm_final + c), wb = *(const f32x4*)(norm_final + c + 4);
            *(f32x4*)(dst + c) = (f32x4){f[j][0], f[j][1], f[j][2], f[j][3]} * rstd * wa; *(f32x4*)(dst + c + 4) = (f32x4){f[j][4], f[j][5], f[j][6], f[j][7]} * rstd * wb; }
    }
    }
}

extern "C" void kernel_launch(void* const* d_in, const int* in_sizes, int n_in, void* d_out, int out_size, void* d_ws, size_t ws_size, hipStream_t stream) {
    static int grid_blocks = 0;
    if (grid_blocks == 0) {
        if (n_in != 22 || (size_t)out_size != O_END || ws_size < WS_END) { fprintf(stderr, "kernel_launch: unexpected shapes (n_in %d out %d ws %zu)\n", n_in, out_size, ws_size); grid_blocks = -1; return; }
        int dev = 0, cus = 0, per_cu = 0;
        hipGetDevice(&dev);
        hipDeviceGetAttribute(&cus, hipDeviceAttributeMultiprocessorCount, dev);
        if (hipFuncSetAttribute((const void*)fwd_megakernel, hipFuncAttributeMaxDynamicSharedMemorySize, LDS_BYTES) != hipSuccess) { fprintf(stderr, "kernel_launch: hipFuncSetAttribute failed\n"); grid_blocks = -1; return; }
        if (hipOccupancyMaxActiveBlocksPerMultiprocessor(&per_cu, (const void*)fwd_megakernel, NTHREADS, LDS_BYTES) != hipSuccess || per_cu < 1) { fprintf(stderr, "kernel_launch: occupancy query failed (%d)\n", per_cu); per_cu = 1; }
        (void)hipGetLastError();
        grid_blocks = cus * 1;
        if (grid_blocks < 128) { fprintf(stderr, "kernel_launch: needs at least 128 CUs\n"); grid_blocks = -1; return; }
        if (per_cu < 1) grid_blocks = -1;
    }
    if (grid_blocks < 0) return;
    if (hipMemsetAsync((char*)d_ws + WS_CTL, 0, 65536, stream) != hipSuccess) { fprintf(stderr, "kernel_launch: memset failed\n"); return; }
    Params p{};
    for (int i = 0; i < 22; ++i) p.in[i] = (const float*)d_in[i];
    p.out = (float*)d_out; p.ws = (unsigned char*)d_ws;
    void* args[] = {&p};
    hipError_t e = hipLaunchCooperativeKernel((const void*)fwd_megakernel, dim3(grid_blocks), dim3(NTHREADS), args, LDS_BYTES, stream);
    if (e != hipSuccess) fprintf(stderr, "cooperative launch failed: %s (grid %d)\n", hipGetErrorString(e), grid_blocks);
}
```
